# Optimizing an MI355X kernel written in HIP

```python
import math
import jax, jax.numpy as jnp
from jax import lax
import numpy as np

D_MODEL = 1024
BATCH = 8
SEQ = 2048
DEPTH = 4

N_HEADS = 8
HEAD_DIM = 64
V_HEAD_DIM = 2 * HEAD_DIM
QK_WIDTH = 2 * N_HEADS * HEAD_DIM
V_WIDTH = N_HEADS * V_HEAD_DIM
CONV_WIDTH = D_MODEL
CONV_GROUPS = 8
CONV_K = 3
SPLIT_SIZES = (QK_WIDTH, QK_WIDTH, V_WIDTH, CONV_WIDTH, CONV_WIDTH, CONV_WIDTH, D_MODEL, D_MODEL)
SPLIT_IDX = (1024, 2048, 3072, 4096, 5120, 6144, 7168)
IN_WIDTH = 8192
D_FF = 2816
N_EXPERTS = 8
TOP_K = 2
D_FF_EXPERT = 3584
N_DENSE = (DEPTH + 1) // 2
N_MOE = DEPTH // 2
ROPE_THETA = 10000.0
RMS_EPS = 1e-5
Q_BLOCK = 128

kernel_name = "hybrid_diffattn_shortconv_moe_trunk"


def rmsnorm(x, g):
    xf = x.astype(jnp.float32)
    y = xf * lax.rsqrt(jnp.mean(xf * xf, axis=-1, keepdims=True) + RMS_EPS)
    return (y * g.astype(jnp.float32)).astype(x.dtype)


def rope_tables(T, dtype):
    pos = jnp.arange(T, dtype=jnp.float32)
    inv = 1.0 / (ROPE_THETA ** (jnp.arange(0, HEAD_DIM, 2, dtype=jnp.float32) / HEAD_DIM))
    ang = pos[:, None] * inv[None, :]
    ang = jnp.concatenate([ang, ang], axis=-1)
    return jnp.cos(ang).astype(dtype), jnp.sin(ang).astype(dtype)


def apply_rope(x, cos, sin):
    x1, x2 = jnp.split(x, 2, axis=-1)
    rot = jnp.concatenate([-x2, x1], axis=-1)
    return x * cos[None, :, None, :] + rot * sin[None, :, None, :]


def diff_attention(q, k, v, lam, lam_init, subln_g):
    B, T = q.shape[0], q.shape[1]
    q = q * (HEAD_DIM ** -0.5)
    neg = jnp.finfo(jnp.float32).min
    outs = []
    for i in range(T // Q_BLOCK):
        q0 = i * Q_BLOCK
        kv_len = q0 + Q_BLOCK
        q_blk = q[:, q0:kv_len]
        k_blk = k[:, :kv_len]
        v_blk = v[:, :kv_len]
        s = jnp.einsum('bqhmd,bkhmd->bhmqk', q_blk, k_blk).astype(jnp.float32)
        q_pos = q0 + jnp.arange(Q_BLOCK)
        k_pos = jnp.arange(kv_len)
        mask = k_pos[None, :] <= q_pos[:, None]
        s = jnp.where(mask[None, None, None], s, neg)
        p = jax.nn.softmax(s, axis=-1)
        p_diff = p[:, :, 0] - lam * p[:, :, 1]
        outs.append(jnp.einsum('bhqk,bkhe->bqhe', p_diff.astype(v.dtype), v_blk))
    o = jnp.concatenate(outs, axis=1)
    o = rmsnorm(o, subln_g) * (1.0 - lam_init)
    return o.reshape(B, T, V_WIDTH)


def causal_short_conv(u, w):
    T = u.shape[1]
    up = jnp.pad(u, ((0, 0), (CONV_K - 1, 0), (0, 0)))
    y = w[0] * up[:, 0:T]
    for j in range(1, CONV_K):
        y = y + w[j] * up[:, j:j + T]
    return y


def hybrid_mixer(h, w_in, conv_w, lam_q1, lam_k1, lam_q2, lam_k2, subln_g, w_out,
                 layer_idx, cos, sin):
    B, T, _ = h.shape
    proj = h @ w_in
    q, k, v, b_g, c_g, u, g_attn, g_conv = jnp.split(proj, SPLIT_IDX, axis=-1)
    q = apply_rope(q.reshape(B, T, 2 * N_HEADS, HEAD_DIM), cos, sin)
    k = apply_rope(k.reshape(B, T, 2 * N_HEADS, HEAD_DIM), cos, sin)
    q = q.reshape(B, T, N_HEADS, 2, HEAD_DIM)
    k = k.reshape(B, T, N_HEADS, 2, HEAD_DIM)
    v = v.reshape(B, T, N_HEADS, V_HEAD_DIM)
    lam_init = 0.8 - 0.6 * math.exp(-0.3 * layer_idx)
    lam = (jnp.exp(jnp.sum(lam_q1.astype(jnp.float32) * lam_k1.astype(jnp.float32)))
           - jnp.exp(jnp.sum(lam_q2.astype(jnp.float32) * lam_k2.astype(jnp.float32)))
           + lam_init)
    y_attn = diff_attention(q, k, v, lam, lam_init, subln_g)
    y_conv = b_g * causal_short_conv(c_g * u, conv_w)
    m = jax.nn.sigmoid(g_attn) * y_attn + jax.nn.sigmoid(g_conv) * y_conv
    return m @ w_out


def swiglu(h, w_gate, w_up, w_down):
    return (jax.nn.silu(h @ w_gate) * (h @ w_up)) @ w_down


def moe_swiglu(h, w_router, e_gate, e_up, e_down):
    B, T, D = h.shape
    xt = h.reshape(B * T, D)
    logits = (xt @ w_router).astype(jnp.float32)
    top_vals, top_idx = lax.top_k(logits, TOP_K)
    top_w = jax.nn.softmax(top_vals, axis=-1)
    gates = jnp.sum(jax.nn.one_hot(top_idx, N_EXPERTS, dtype=jnp.float32) * top_w[..., None],
                    axis=1).astype(h.dtype)
    y = jnp.zeros_like(xt)
    for e in range(N_EXPERTS):
        y = y + gates[:, e:e + 1] * swiglu(xt, e_gate[e], e_up[e], e_down[e])
    return y.reshape(B, T, D)


def setup_inputs(seed: int = 0) -> dict:
    key = jax.random.key(seed)
    ks = jax.random.split(key, 24)
    f32 = jnp.float32
    nrm = lambda k, shape, scale: jax.random.normal(k, shape, f32) * scale
    return {
        "x": nrm(ks[0], (BATCH, SEQ, D_MODEL), 1.0),
        "norm_mix": 1.0 + nrm(ks[1], (DEPTH, D_MODEL), 0.02),
        "w_in": nrm(ks[2], (DEPTH, D_MODEL, IN_WIDTH), D_MODEL ** -0.5),
        "conv_w": nrm(ks[3], (DEPTH, CONV_K, CONV_WIDTH), CONV_K ** -0.5),
        "lam_q1": nrm(ks[4], (DEPTH, HEAD_DIM), 0.1),
        "lam_k1": nrm(ks[5], (DEPTH, HEAD_DIM), 0.1),
        "lam_q2": nrm(ks[6], (DEPTH, HEAD_DIM), 0.1),
        "lam_k2": nrm(ks[7], (DEPTH, HEAD_DIM), 0.1),
        "subln_g": 1.0 + nrm(ks[8], (DEPTH, V_HEAD_DIM), 0.02),
        "w_out": nrm(ks[9], (DEPTH, D_MODEL, D_MODEL), D_MODEL ** -0.5),
        "norm_ffn": 1.0 + nrm(ks[10], (DEPTH, D_MODEL), 0.02),
        "ffn_w_gate": nrm(ks[11], (N_DENSE, D_MODEL, D_FF), D_MODEL ** -0.5),
        "ffn_w_up": nrm(ks[12], (N_DENSE, D_MODEL, D_FF), D_MODEL ** -0.5),
        "ffn_w_down": nrm(ks[13], (N_DENSE, D_FF, D_MODEL), D_FF ** -0.5),
        "router_w": nrm(ks[14], (N_MOE, D_MODEL, N_EXPERTS), D_MODEL ** -0.5),
        "exp_w_gate": nrm(ks[15], (N_MOE, N_EXPERTS, D_MODEL, D_FF_EXPERT), D_MODEL ** -0.5),
        "exp_w_up": nrm(ks[16], (N_MOE, N_EXPERTS, D_MODEL, D_FF_EXPERT), D_MODEL ** -0.5),
        "exp_w_down": nrm(ks[17], (N_MOE, N_EXPERTS, D_FF_EXPERT, D_MODEL), D_FF_EXPERT ** -0.5),
        "norm_final": 1.0 + nrm(ks[18], (D_MODEL,), 0.02),
    }


def reference(x, norm_mix, w_in, conv_w, lam_q1, lam_k1, lam_q2, lam_k2, subln_g, w_out,
              norm_ffn, ffn_w_gate, ffn_w_up, ffn_w_down, router_w, exp_w_gate, exp_w_up,
              exp_w_down, norm_final):
    T = x.shape[1]
    cos, sin = rope_tables(T, x.dtype)
    for l in range(DEPTH):
        h = rmsnorm(x, norm_mix[l])
        x = x + hybrid_mixer(h, w_in[l], conv_w[l], lam_q1[l], lam_k1[l], lam_q2[l], lam_k2[l],
                             subln_g[l], w_out[l], l, cos, sin)
        h = rmsnorm(x, norm_ffn[l])
        j = l // 2
        if l % 2 == 0:
            x = x + swiglu(h, ffn_w_gate[j], ffn_w_up[j], ffn_w_down[j])
        else:
            x = x + moe_swiglu(h, router_w[j], exp_w_gate[j], exp_w_up[j], exp_w_down[j])
    return rmsnorm(x, norm_final)
```

```cpp
#include <hip/hip_runtime.h>
#include <stdint.h>
#include <stdio.h>

typedef unsigned short u16;
using bf16x8 = __attribute__((ext_vector_type(8))) short;
using s16x4  = __attribute__((ext_vector_type(4))) short;
using f32x16 = __attribute__((ext_vector_type(16))) float;

#define MFMA16(a, b, c) __builtin_amdgcn_mfma_f32_32x32x16_bf16((a), (b), (c), 0, 0, 0)
#define MFMA8(a, b, c)  __builtin_amdgcn_mfma_f32_32x32x8bf16_1k((a), (b), (c), 0, 0, 0)

#define NTOK   16384
#define DM     1024
#define SEQ    2048
#define INW    8192
#define DFF    2816
#define DFE    3584
#define NEXP   8

#define XB_TMO      128
#define XB_XCNT(j)  (256  + 64 * (j))
#define XB_XSUB(j)  (1280 + 64 * (j))
#define XB_XGEN(j)  (2304 + 64 * (j))
#define XB_TOP      3328
#define XB_TOPGEN   3392
#define XCD_BAR_WORDS 3456
#define XB_SPIN_CAP (1u << 24)
#define LAS __attribute__((address_space(3)))

__device__ __forceinline__ unsigned xb_ld(unsigned* p)              { return __hip_atomic_load(p, __ATOMIC_RELAXED, __HIP_MEMORY_SCOPE_AGENT); }
__device__ __forceinline__ unsigned xb_add(unsigned* p, unsigned v) { return __hip_atomic_fetch_add(p, v, __ATOMIC_RELAXED, __HIP_MEMORY_SCOPE_AGENT); }
__device__ __forceinline__ unsigned xb_xcc_id() { return (unsigned)__builtin_amdgcn_s_getreg((3 << 11) | 20) & 0xFu; }
#define XB_SPIN(cond, bar) do { unsigned _sp = 0; while (cond) { __builtin_amdgcn_s_sleep(1); \
    if ((++_sp & 255u) == 0u) { if (xb_ld(&(bar)[XB_TMO])) break; if (_sp > XB_SPIN_CAP) { atomicAdd(&(bar)[XB_TMO], 1u); break; } } } } while (0)

struct XcdBarrier { unsigned* bar; unsigned x; volatile LAS unsigned* st; };

__device__ __forceinline__ XcdBarrier xcd_barrier_post(unsigned* bar, volatile LAS unsigned* st) {
    XcdBarrier b; b.bar = bar; b.x = xb_xcc_id(); b.st = st;
    if (threadIdx.x == 0) (void)xb_add(&bar[XB_XCNT(b.x)], 1u);
    return b;
}
__device__ __forceinline__ void xcd_barrier_complete(unsigned* bar, unsigned x, unsigned& nloc, unsigned& nx) {
    const unsigned G = gridDim.x * gridDim.y * gridDim.z;
    unsigned sum, cnt, mine, sp = 0u;
    for (;;) {
        sum = 0u; cnt = 0u; mine = 0u;
#pragma unroll
        for (unsigned j = 0; j < 16; ++j) { const unsigned c = xb_ld(&bar[XB_XCNT(j)]); sum += c; cnt += (c > 0u) ? 1u : 0u; mine = (j == x) ? c : mine; }
        if (sum == G) break;
        __builtin_amdgcn_s_sleep(1);
        if ((++sp & 255u) == 0u) { if (xb_ld(&bar[XB_TMO])) break; if (sp > XB_SPIN_CAP) { atomicAdd(&bar[XB_TMO], 1u); break; } }
    }
    nloc = mine > 0u ? mine : 1u; nx = cnt > 0u ? cnt : 1u;
}
__device__ __forceinline__ void xcd_barrier(const XcdBarrier b) {
    asm volatile("s_waitcnt vmcnt(0)" ::: "memory");
    __syncthreads();
    if (threadIdx.x == 0) {
        unsigned* bar = b.bar;
        __builtin_amdgcn_s_waitcnt(0);
        unsigned nloc = b.st[0], nx = b.st[1];
        if (nloc == 0u) { xcd_barrier_complete(bar, b.x, nloc, nx); b.st[0] = nloc; b.st[1] = nx; }
        const unsigned old = xb_add(&bar[XB_XSUB(b.x)], 1u);
        const unsigned gen = old / nloc;
        if (old + 1u == (gen + 1u) * nloc) {
            __builtin_amdgcn_fence(__ATOMIC_RELEASE, "agent");
            asm volatile("s_waitcnt vmcnt(0)" ::: "memory");
            const unsigned og = xb_add(&bar[XB_TOP], 1u);
            const unsigned tg = og / nx;
            if (og + 1u == (tg + 1u) * nx) xb_add(&bar[XB_TOPGEN], 1u);
            else XB_SPIN(xb_ld(&bar[XB_TOPGEN]) == tg, bar);
            __builtin_amdgcn_fence(__ATOMIC_ACQUIRE, "agent");
            xb_add(&bar[XB_XGEN(b.x)], 1u);
            asm volatile("s_waitcnt vmcnt(0)" ::: "memory");
        } else {
            XB_SPIN(xb_ld(&bar[XB_XGEN(b.x)]) == gen, bar);
            __builtin_amdgcn_fence(__ATOMIC_ACQUIRE, "agent");
            asm volatile("s_waitcnt vmcnt(0)" ::: "memory");
        }
    }
    __syncthreads();
}

__device__ __forceinline__ u16 f2bf(float f) {
    uint32_t u = __float_as_uint(f);
    u += 0x7fffu + ((u >> 16) & 1u);
    return (u16)(u >> 16);
}
__device__ __forceinline__ float bf2f(u16 h) { return __uint_as_float(((uint32_t)h) << 16); }
__device__ __forceinline__ float sigm(float x) { return 1.0f / (1.0f + __expf(-x)); }
__device__ __forceinline__ float wave_sum(float v) {
#pragma unroll
    for (int o = 32; o >= 1; o >>= 1) v += __shfl_xor(v, o);
    return v;
}

struct Params {
    const float *x, *norm_mix, *w_in, *conv_w, *lam_q1, *lam_k1, *lam_q2, *lam_k2, *subln_g, *w_out, *norm_ffn;
    const float *ffn_w_gate, *ffn_w_up, *ffn_w_down, *router_w, *exp_w_gate, *exp_w_up, *exp_w_down, *norm_final;
    float* out;
    unsigned* bar;
    int* counts;
    float* cosT;
    float* sinT;
    float* xbuf;
    u16* h;
    u16* mbuf;
    u16* Vt;
    int* topi;
    float* topw;
    int* list;
    u16* R1;
    float* Y;
    u16* w_in_t;
    u16* w_out_t;
    u16* wf;
};

struct EpiArgs {
    u16* proj; u16* Vt; const float* cosT; const float* sinT;
    float* xbuf;
    u16* H; int ldh; int orow_off;
    float* Y; const float* topw; const int* rowlist; int mvalid;
};

enum { EPI_INPROJ = 0, EPI_RESID = 1, EPI_SWIGLU = 2, EPI_MOEDOWN = 3 };

#define LDT 40

template <int EPI, bool DUAL>
__device__ __forceinline__ void gemm_tile(const u16* __restrict__ A, int lda, const int* __restrict__ gather, int mvalid, int m0,
                                          const u16* __restrict__ B0, const u16* __restrict__ B1, int K, int n0,
                                          const Params& p, int e_ldh, int e_orow, const int* e_rowlist, int e_mvalid, u16* smem)
{
    u16* As = smem; u16* Bs0 = smem + 128 * LDT; u16* Bs1 = smem + 2 * 128 * LDT;
    const int tid = threadIdx.x, lane = tid & 63, wave = tid >> 6;
    const int wm = (wave >> 1) * 64, wn = (wave & 1) * 64;
    const int l32 = lane & 31, half = lane >> 5;

    const int row0 = tid >> 2, row1 = (tid + 256) >> 2, sg8 = (tid & 3) * 8;
    int ar0 = m0 + row0, ar1 = m0 + row1;
    if (gather) { ar0 = (ar0 < mvalid) ? (gather[ar0] >> 1) : 0; ar1 = (ar1 < mvalid) ? (gather[ar1] >> 1) : 0; }
    const u16* ap0 = A + (size_t)ar0 * lda + sg8;
    const u16* ap1 = A + (size_t)ar1 * lda + sg8;
    const u16* bpa0 = B0 + (size_t)(n0 + row0) * K + sg8;
    const u16* bpa1 = B0 + (size_t)(n0 + row1) * K + sg8;
    const u16* bpb0 = DUAL ? (B1 + (size_t)(n0 + row0) * K + sg8) : bpa0;
    const u16* bpb1 = DUAL ? (B1 + (size_t)(n0 + row1) * K + sg8) : bpa1;
    const int so0 = row0 * LDT + sg8, so1 = row1 * LDT + sg8;
    f32x16 acc[DUAL ? 2 : 1][2][2];
#pragma unroll
    for (int d = 0; d < (DUAL ? 2 : 1); ++d)
#pragma unroll
        for (int i = 0; i < 2; ++i)
#pragma unroll
            for (int j = 0; j < 2; ++j)
#pragma unroll
                for (int r = 0; r < 16; ++r) acc[d][i][j][r] = 0.f;

    uint4 ra0 = *(const uint4*)ap0, ra1 = *(const uint4*)ap1;
    uint4 rba0 = *(const uint4*)bpa0, rba1 = *(const uint4*)bpa1;
    uint4 rbb0 = rba0, rbb1 = rba1;
    if (DUAL) { rbb0 = *(const uint4*)bpb0; rbb1 = *(const uint4*)bpb1; }
    const int nk = K >> 5;
    for (int kt = 0; kt < nk; ++kt) {
        __syncthreads();
        *(uint4*)(As + so0) = ra0; *(uint4*)(As + so1) = ra1;
        *(uint4*)(Bs0 + so0) = rba0; *(uint4*)(Bs0 + so1) = rba1;
        if (DUAL) { *(uint4*)(Bs1 + so0) = rbb0; *(uint4*)(Bs1 + so1) = rbb1; }
        __syncthreads();
        if (kt + 1 < nk) {
            const int ko = (kt + 1) * 32;
            ra0 = *(const uint4*)(ap0 + ko); ra1 = *(const uint4*)(ap1 + ko);
            rba0 = *(const uint4*)(bpa0 + ko); rba1 = *(const uint4*)(bpa1 + ko);
            if (DUAL) { rbb0 = *(const uint4*)(bpb0 + ko); rbb1 = *(const uint4*)(bpb1 + ko); }
        }
#pragma unroll
        for (int ks = 0; ks < 2; ++ks) {
            bf16x8 af[2], bf[2], bg[2];
#pragma unroll
            for (int i = 0; i < 2; ++i) af[i] = *(const bf16x8*)(As + (wm + i * 32 + l32) * LDT + ks * 16 + half * 8);
#pragma unroll
            for (int j = 0; j < 2; ++j) {
                bf[j] = *(const bf16x8*)(Bs0 + (wn + j * 32 + l32) * LDT + ks * 16 + half * 8);
                if (DUAL) bg[j] = *(const bf16x8*)(Bs1 + (wn + j * 32 + l32) * LDT + ks * 16 + half * 8);
            }
#pragma unroll
            for (int i = 0; i < 2; ++i)
#pragma unroll
                for (int j = 0; j < 2; ++j) {
                    acc[0][i][j] = MFMA16(af[i], bf[j], acc[0][i][j]);
                    if (DUAL) acc[DUAL ? 1 : 0][i][j] = MFMA16(af[i], bg[j], acc[DUAL ? 1 : 0][i][j]);
                }
        }
    }

    if (EPI == EPI_INPROJ) {
        const int seg = n0 >> 10;
        if (seg < 2) {
            const float qs = (seg == 0) ? 0.125f : 1.0f;
#pragma unroll
            for (int i = 0; i < 2; ++i)
#pragma unroll
                for (int r = 0; r < 16; ++r) {
                    const int m = m0 + wm + i * 32 + (r >> 2) * 8 + half * 4 + (r & 3);
                    const int pos = m & (SEQ - 1);
                    const float c = p.cosT[pos * 32 + l32], s = p.sinT[pos * 32 + l32];
                    const float x1 = acc[0][i][0][r], x2 = acc[0][i][1][r];
                    const float o1 = (x1 * c - x2 * s) * qs, o2 = (x2 * c + x1 * s) * qs;
                    u16* dst = p.R1 + (size_t)m * INW + n0 + wn + l32;
                    dst[0] = f2bf(o1); dst[32] = f2bf(o2);
                }
        } else if (seg == 2) {
#pragma unroll
            for (int i = 0; i < 2; ++i)
#pragma unroll
                for (int j = 0; j < 2; ++j)
#pragma unroll
                    for (int rq = 0; rq < 4; ++rq) {
                        const int m = m0 + wm + i * 32 + rq * 8 + half * 4;
                        const int b = m >> 11, t = m & (SEQ - 1);
                        const int nn = n0 - 2048 + wn + j * 32 + l32;
                        ushort4 v;
                        v.x = f2bf(acc[0][i][j][rq * 4 + 0]); v.y = f2bf(acc[0][i][j][rq * 4 + 1]);
                        v.z = f2bf(acc[0][i][j][rq * 4 + 2]); v.w = f2bf(acc[0][i][j][rq * 4 + 3]);
                        *(ushort4*)(p.Vt + ((size_t)(b * 1024 + nn)) * SEQ + t) = v;
                    }
        } else {
#pragma unroll
            for (int i = 0; i < 2; ++i)
#pragma unroll
                for (int j = 0; j < 2; ++j)
#pragma unroll
                    for (int r = 0; r < 16; ++r) {
                        const int m = m0 + wm + i * 32 + (r >> 2) * 8 + half * 4 + (r & 3);
                        p.R1[(size_t)m * INW + n0 + wn + j * 32 + l32] = f2bf(acc[0][i][j][r]);
                    }
        }
    } else if (EPI == EPI_RESID) {
#pragma unroll
        for (int i = 0; i < 2; ++i)
#pragma unroll
            for (int j = 0; j < 2; ++j)
#pragma unroll
                for (int r = 0; r < 16; ++r) {
                    const int m = m0 + wm + i * 32 + (r >> 2) * 8 + half * 4 + (r & 3);
                    float* xp = p.xbuf + (size_t)m * DM + n0 + wn + j * 32 + l32;
                    *xp = *xp + acc[0][i][j][r];
                }
    } else if (EPI == EPI_SWIGLU) {
#pragma unroll
        for (int i = 0; i < 2; ++i)
#pragma unroll
            for (int j = 0; j < 2; ++j)
#pragma unroll
                for (int r = 0; r < 16; ++r) {
                    const int m = m0 + wm + i * 32 + (r >> 2) * 8 + half * 4 + (r & 3) + e_orow;
                    const float g = acc[0][i][j][r], u = acc[DUAL ? 1 : 0][i][j][r];
                    p.R1[(size_t)m * e_ldh + n0 + wn + j * 32 + l32] = f2bf(g * sigm(g) * u);
                }
    } else {
#pragma unroll
        for (int i = 0; i < 2; ++i)
#pragma unroll
            for (int r = 0; r < 16; ++r) {
                const int lm = m0 + wm + i * 32 + (r >> 2) * 8 + half * 4 + (r & 3);
                if (lm < e_mvalid) {
                    const int ent = e_rowlist[lm];
                    const float w = p.topw[ent];
#pragma unroll
                    for (int j = 0; j < 2; ++j)
                        p.Y[(size_t)ent * DM + n0 + wn + j * 32 + l32] = w * acc[0][i][j][r];
                }
            }
    }
}

__device__ void convert_job(const float* __restrict__ src, u16* __restrict__ dst, int K, int N, int batch, u16* T)
{
    const int tid = threadIdx.x;
    const int tk = K >> 6, tn = N >> 6; const int per = tk * tn; const int total = per * batch;
    for (int tile = blockIdx.x; tile < total; tile += gridDim.x) {
        const int bi = tile / per; const int r = tile - bi * per; const int kt = r / tn, nt = r - kt * tn;
        const float* s = src + (size_t)bi * K * N + (size_t)(kt * 64) * N + nt * 64;
        u16* d = dst + (size_t)bi * K * N + (size_t)(nt * 64) * K + kt * 64;
        __syncthreads();
#pragma unroll
        for (int i = 0; i < 4; ++i) {
            const int k = (tid >> 4) + 16 * i; const int n4 = (tid & 15) * 4;
            const float4 v = *(const float4*)(s + (size_t)k * N + n4);
            T[(n4 + 0) * 72 + k] = f2bf(v.x); T[(n4 + 1) * 72 + k] = f2bf(v.y);
            T[(n4 + 2) * 72 + k] = f2bf(v.z); T[(n4 + 3) * 72 + k] = f2bf(v.w);
        }
        __syncthreads();
#pragma unroll
        for (int i = 0; i < 2; ++i) {
            const int c = tid + 256 * i; const int n = c >> 3, seg = c & 7;
            const uint4 v = *(const uint4*)(T + n * 72 + seg * 8);
            *(uint4*)(d + (size_t)n * K + seg * 8) = v;
        }
    }
}

__device__ void rownorm_phase(const float* __restrict__ xsrc, const float* __restrict__ Y, float* __restrict__ xdst,
                              const float* __restrict__ g, u16* __restrict__ hout, float* __restrict__ fout,
                              const float* __restrict__ router, int* __restrict__ topi, float* __restrict__ topw)
{
    const int lane = threadIdx.x & 63, wave = threadIdx.x >> 6;
    for (int row = blockIdx.x * 4 + wave; row < NTOK; row += gridDim.x * 4) {
        float4 v[4]; float ss = 0.f;
#pragma unroll
        for (int i = 0; i < 4; ++i) {
            const int d = i * 256 + lane * 4;
            v[i] = *(const float4*)(xsrc + (size_t)row * DM + d);
            if (Y) {
                const float4 y0 = *(const float4*)(Y + (size_t)(row * 2) * DM + d);
                const float4 y1 = *(const float4*)(Y + (size_t)(row * 2 + 1) * DM + d);
                v[i].x += y0.x + y1.x; v[i].y += y0.y + y1.y; v[i].z += y0.z + y1.z; v[i].w += y0.w + y1.w;
            }
            if (xdst) *(float4*)(xdst + (size_t)row * DM + d) = v[i];
            ss += v[i].x * v[i].x + v[i].y * v[i].y + v[i].z * v[i].z + v[i].w * v[i].w;
        }
        ss = wave_sum(ss);
        const float rs = rsqrtf(ss * (1.0f / DM) + 1e-5f);
        float lg[8];
#pragma unroll
        for (int e = 0; e < 8; ++e) lg[e] = 0.f;
#pragma unroll
        for (int i = 0; i < 4; ++i) {
            const int d = i * 256 + lane * 4;
            const float4 gv = *(const float4*)(g + d);
            float4 y; y.x = v[i].x * rs * gv.x; y.y = v[i].y * rs * gv.y; y.z = v[i].z * rs * gv.z; y.w = v[i].w * rs * gv.w;
            if (hout) {
                ushort4 o; o.x = f2bf(y.x); o.y = f2bf(y.y); o.z = f2bf(y.z); o.w = f2bf(y.w);
                *(ushort4*)(hout + (size_t)row * DM + d) = o;
            }
            if (fout) *(float4*)(fout + (size_t)row * DM + d) = y;
            if (router) {
                const float yy[4] = {y.x, y.y, y.z, y.w};
#pragma unroll
                for (int jj = 0; jj < 4; ++jj) {
                    const float4 r0 = *(const float4*)(router + (size_t)(d + jj) * 8);
                    const float4 r1 = *(const float4*)(router + (size_t)(d + jj) * 8 + 4);
                    lg[0] += yy[jj] * r0.x; lg[1] += yy[jj] * r0.y; lg[2] += yy[jj] * r0.z; lg[3] += yy[jj] * r0.w;
                    lg[4] += yy[jj] * r1.x; lg[5] += yy[jj] * r1.y; lg[6] += yy[jj] * r1.z; lg[7] += yy[jj] * r1.w;
                }
            }
        }
        if (router) {
#pragma unroll
            for (int e = 0; e < 8; ++e) lg[e] = wave_sum(lg[e]);
            float b0 = lg[0]; int i0 = 0;
#pragma unroll
            for (int e = 1; e < 8; ++e) if (lg[e] > b0) { b0 = lg[e]; i0 = e; }
            float b1 = -3.0e38f; int i1 = 0;
#pragma unroll
            for (int e = 0; e < 8; ++e) if (e != i0 && lg[e] > b1) { b1 = lg[e]; i1 = e; }
            const float w0 = 1.0f / (1.0f + __expf(b1 - b0));
            if (lane == 0) {
                topi[row * 2] = i0; topi[row * 2 + 1] = i1;
                topw[row * 2] = w0; topw[row * 2 + 1] = 1.0f - w0;
            }
        }
    }
}

__device__ void attn_unit(const Params& p, int l, int b, int hh, int qb, float lam, float lam_init, u16* smem)
{
    u16* Ks = smem;
    u16* Vs = smem + 64 * 72;
    const int tid = threadIdx.x, lane = tid & 63, wave = tid >> 6;
    const int l32 = lane & 31, half = lane >> 5;
    const int q0 = qb * 128 + wave * 32;
    const int tq = q0 + l32;
    const u16* proj = p.R1;
    const size_t rowq = (size_t)(b * SEQ + tq) * INW;
    const int nkv = (qb * 128 + 128) >> 6;

    f32x16 res[4];
#pragma unroll 1
    for (int map = 0; map < 2; ++map) {
        bf16x8 qf[4];
#pragma unroll
        for (int ks = 0; ks < 4; ++ks) qf[ks] = *(const bf16x8*)(proj + rowq + (2 * hh + map) * 64 + ks * 16 + half * 8);
        float m_i = -1.0e30f, l_i = 0.f;
        f32x16 acc[4];
#pragma unroll
        for (int et = 0; et < 4; ++et)
#pragma unroll
            for (int r = 0; r < 16; ++r) acc[et][r] = 0.f;

        for (int kt = 0; kt < nkv; ++kt) {
            const int key0 = kt * 64;
            __syncthreads();
#pragma unroll
            for (int i = 0; i < 2; ++i) {
                const int c = tid + 256 * i; const int row = c >> 3, seg = c & 7;
                *(uint4*)(Ks + row * 72 + seg * 8) =
                    *(const uint4*)(proj + (size_t)(b * SEQ + key0 + row) * INW + 1024 + (2 * hh + map) * 64 + seg * 8);
            }
#pragma unroll
            for (int i = 0; i < 4; ++i) {
                const int c = tid + 256 * i; const int row = c >> 3, seg = c & 7;
                *(uint4*)(Vs + row * 72 + seg * 8) =
                    *(const uint4*)(p.Vt + ((size_t)((b * 8 + hh) * 128 + row)) * SEQ + key0 + seg * 8);
            }
            __syncthreads();
            if (key0 <= q0 + 31) {
                f32x16 st[2];
#pragma unroll
                for (int kb = 0; kb < 2; ++kb) {
#pragma unroll
                    for (int r = 0; r < 16; ++r) st[kb][r] = 0.f;
#pragma unroll
                    for (int ks = 0; ks < 4; ++ks) {
                        const bf16x8 kf = *(const bf16x8*)(Ks + (kb * 32 + l32) * 72 + ks * 16 + half * 8);
                        st[kb] = MFMA16(kf, qf[ks], st[kb]);
                    }
                }
                float mx = -1.0e30f;
#pragma unroll
                for (int kb = 0; kb < 2; ++kb)
#pragma unroll
                    for (int r = 0; r < 16; ++r) {
                        const int key = key0 + kb * 32 + (r >> 2) * 8 + half * 4 + (r & 3);
                        if (key > tq) st[kb][r] = -1.0e30f;
                        mx = fmaxf(mx, st[kb][r]);
                    }
                mx = fmaxf(mx, __shfl_xor(mx, 32));
                const float mnew = fmaxf(m_i, mx);
                const float alpha = __expf(m_i - mnew);
                float rsum = 0.f;
#pragma unroll
                for (int kb = 0; kb < 2; ++kb)
#pragma unroll
                    for (int r = 0; r < 16; ++r) { const float e = __expf(st[kb][r] - mnew); st[kb][r] = e; rsum += e; }
                rsum += __shfl_xor(rsum, 32);
                l_i = l_i * alpha + rsum; m_i = mnew;
#pragma unroll
                for (int et = 0; et < 4; ++et)
#pragma unroll
                    for (int r = 0; r < 16; ++r) acc[et][r] *= alpha;
#pragma unroll
                for (int kb = 0; kb < 2; ++kb)
#pragma unroll
                    for (int kk = 0; kk < 4; ++kk) {
                        s16x4 pb;
                        pb[0] = (short)f2bf(st[kb][kk * 4 + 0]); pb[1] = (short)f2bf(st[kb][kk * 4 + 1]);
                        pb[2] = (short)f2bf(st[kb][kk * 4 + 2]); pb[3] = (short)f2bf(st[kb][kk * 4 + 3]);
#pragma unroll
                        for (int et = 0; et < 4; ++et) {
                            const s16x4 vf = *(const s16x4*)(Vs + (et * 32 + l32) * 72 + kb * 32 + kk * 8 + half * 4);
                            acc[et] = MFMA8(vf, pb, acc[et]);
                        }
                    }
            }
        }
        const float inv = 1.0f / l_i;
        float* tmp = p.Y + (size_t)(b * SEQ + tq) * DM + hh * 128;
        if (map == 0) {
#pragma unroll
            for (int et = 0; et < 4; ++et)
#pragma unroll
                for (int rq = 0; rq < 4; ++rq) {
                    float4 v; v.x = acc[et][rq * 4 + 0] * inv; v.y = acc[et][rq * 4 + 1] * inv;
                    v.z = acc[et][rq * 4 + 2] * inv; v.w = acc[et][rq * 4 + 3] * inv;
                    *(float4*)(tmp + et * 32 + rq * 8 + half * 4) = v;
                }
        } else {
            const float li = lam * inv;
#pragma unroll
            for (int et = 0; et < 4; ++et)
#pragma unroll
                for (int rq = 0; rq < 4; ++rq) {
                    const float4 v = *(const float4*)(tmp + et * 32 + rq * 8 + half * 4);
                    res[et][rq * 4 + 0] = v.x - acc[et][rq * 4 + 0] * li; res[et][rq * 4 + 1] = v.y - acc[et][rq * 4 + 1] * li;
                    res[et][rq * 4 + 2] = v.z - acc[et][rq * 4 + 2] * li; res[et][rq * 4 + 3] = v.w - acc[et][rq * 4 + 3] * li;
                }
        }
    }
    float ss = 0.f;
#pragma unroll
    for (int et = 0; et < 4; ++et)
#pragma unroll
        for (int r = 0; r < 16; ++r) ss += res[et][r] * res[et][r];
    ss += __shfl_xor(ss, 32);
    const float rs = rsqrtf(ss * (1.0f / 128.0f) + 1e-5f) * (1.0f - lam_init);
    float* tmp2 = p.Y + (size_t)(b * SEQ + tq) * DM + hh * 128;
#pragma unroll
    for (int et = 0; et < 4; ++et)
#pragma unroll
        for (int rq = 0; rq < 4; ++rq) {
            float4 v; v.x = res[et][rq * 4 + 0] * rs; v.y = res[et][rq * 4 + 1] * rs;
            v.z = res[et][rq * 4 + 2] * rs; v.w = res[et][rq * 4 + 3] * rs;
            *(float4*)(tmp2 + et * 32 + rq * 8 + half * 4) = v;
        }
    const float* cw = p.conv_w + (size_t)l * 3 * DM;
    const float* sg = p.subln_g + (size_t)l * 128;
    const u16* r0p = proj + rowq;
    const u16* r1p = proj + rowq - INW;
    const u16* r2p = proj + rowq - 2 * INW;
    const bool h1 = tq >= 1, h2 = tq >= 2;
#pragma unroll 1
    for (int gi = 0; gi < 16; ++gi) {
        const int e4 = (gi >> 2) * 32 + (gi & 3) * 8 + half * 4;
        const int ch = hh * 128 + e4;
        const float4 yv = *(const float4*)(tmp2 + e4);
        const ushort4 bg = *(const ushort4*)(r0p + 3072 + ch);
        const ushort4 c0 = *(const ushort4*)(r0p + 4096 + ch);
        const ushort4 u0 = *(const ushort4*)(r0p + 5120 + ch);
        const ushort4 ga = *(const ushort4*)(r0p + 6144 + ch);
        const ushort4 gc = *(const ushort4*)(r0p + 7168 + ch);
        ushort4 c1 = make_ushort4(0, 0, 0, 0), u1 = c1, c2 = c1, u2 = c1;
        if (h1) { c1 = *(const ushort4*)(r1p + 4096 + ch); u1 = *(const ushort4*)(r1p + 5120 + ch); }
        if (h2) { c2 = *(const ushort4*)(r2p + 4096 + ch); u2 = *(const ushort4*)(r2p + 5120 + ch); }
        const float4 w0 = *(const float4*)(cw + ch);
        const float4 w1 = *(const float4*)(cw + DM + ch);
        const float4 w2 = *(const float4*)(cw + 2 * DM + ch);
        const float4 sgv = *(const float4*)(sg + e4);
        ushort4 o;
        {
            const float ya = yv.x * sgv.x;
            const float cv = w0.x * bf2f(c2.x) * bf2f(u2.x) + w1.x * bf2f(c1.x) * bf2f(u1.x) + w2.x * bf2f(c0.x) * bf2f(u0.x);
            o.x = f2bf(sigm(bf2f(ga.x)) * ya + sigm(bf2f(gc.x)) * bf2f(bg.x) * cv);
        }
        {
            const float ya = yv.y * sgv.y;
            const float cv = w0.y * bf2f(c2.y) * bf2f(u2.y) + w1.y * bf2f(c1.y) * bf2f(u1.y) + w2.y * bf2f(c0.y) * bf2f(u0.y);
            o.y = f2bf(sigm(bf2f(ga.y)) * ya + sigm(bf2f(gc.y)) * bf2f(bg.y) * cv);
        }
        {
            const float ya = yv.z * sgv.z;
            const float cv = w0.z * bf2f(c2.z) * bf2f(u2.z) + w1.z * bf2f(c1.z) * bf2f(u1.z) + w2.z * bf2f(c0.z) * bf2f(u0.z);
            o.z = f2bf(sigm(bf2f(ga.z)) * ya + sigm(bf2f(gc.z)) * bf2f(bg.z) * cv);
        }
        {
            const float ya = yv.w * sgv.w;
            const float cv = w0.w * bf2f(c2.w) * bf2f(u2.w) + w1.w * bf2f(c1.w) * bf2f(u1.w) + w2.w * bf2f(c0.w) * bf2f(u0.w);
            o.w = f2bf(sigm(bf2f(ga.w)) * ya + sigm(bf2f(gc.w)) * bf2f(bg.w) * cv);
        }
        *(ushort4*)(p.mbuf + (size_t)(b * SEQ + tq) * DM + ch) = o;
    }
}

template <int PH>
__device__ __forceinline__ void run_phase(const Params& p, int l, u16* smem, int* wsum)
{
    const int tid = threadIdx.x, lane = tid & 63, wave = tid >> 6;
    const int G = gridDim.x;
    const int j = l >> 1; const bool moe = (l & 1);

    if (PH == 0) {
        if (l == 0) {
            for (int idx = blockIdx.x * 256 + tid; idx < SEQ * 32; idx += G * 256) {
                const int pos = idx >> 5, jj = idx & 31;
                const float inv = exp2f(-(float)jj * (13.287712379549449f / 32.0f));
                const float ang = (float)pos * inv;
                double rev = (double)ang * 0.15915494309189535;
                rev -= rint(rev);
                p.cosT[idx] = __builtin_amdgcn_cosf((float)rev);
                p.sinT[idx] = __builtin_amdgcn_sinf((float)rev);
            }
        }
        convert_job(p.w_in + (size_t)l * DM * INW, p.w_in_t, DM, INW, 1, smem);
        convert_job(p.w_out + (size_t)l * DM * DM, p.w_out_t, DM, DM, 1, smem);
        if (!moe) {
            convert_job(p.ffn_w_gate + (size_t)j * DM * DFF, p.wf, DM, DFF, 1, smem);
            convert_job(p.ffn_w_up + (size_t)j * DM * DFF, p.wf + (size_t)DM * DFF, DM, DFF, 1, smem);
            convert_job(p.ffn_w_down + (size_t)j * DM * DFF, p.wf + (size_t)2 * DM * DFF, DFF, DM, 1, smem);
        } else {
            const size_t es = (size_t)NEXP * DM * DFE;
            convert_job(p.exp_w_gate + (size_t)j * es, p.wf, DM, DFE, NEXP, smem);
            convert_job(p.exp_w_up + (size_t)j * es, p.wf + es, DM, DFE, NEXP, smem);
            convert_job(p.exp_w_down + (size_t)j * es, p.wf + 2 * es, DFE, DM, NEXP, smem);
        }
        rownorm_phase(l == 0 ? p.x : p.xbuf, (l > 0 && ((l - 1) & 1)) ? p.Y : nullptr, p.xbuf,
                      p.norm_mix + (size_t)l * DM, p.h, nullptr, nullptr, nullptr, nullptr);
    } else if (PH == 1) {
        const int NT = INW / 128, total = (NTOK / 128) * NT;
        for (int tile = blockIdx.x; tile < total; tile += G) {
            const int mt = tile / NT, nt = tile - mt * NT;
            gemm_tile<EPI_INPROJ, false>(p.h, DM, nullptr, 0, mt * 128, p.w_in_t, nullptr, DM, nt * 128, p, 0, 0, nullptr, 0, smem);
        }
    } else if (PH == 2) {
        const float lam_init = 0.8f - 0.6f * expf(-0.3f * (float)l);
        float d1 = p.lam_q1[l * 64 + lane] * p.lam_k1[l * 64 + lane];
        float d2 = p.lam_q2[l * 64 + lane] * p.lam_k2[l * 64 + lane];
        d1 = wave_sum(d1); d2 = wave_sum(d2);
        const float lam = expf(d1) - expf(d2) + lam_init;
        for (int u = blockIdx.x; u < 1024; u += G) {
            const int qb = 15 - (u >> 6); const int bh = u & 63;
            attn_unit(p, l, bh >> 3, bh & 7, qb, lam, lam_init, smem);
        }
    } else if (PH == 3) {
        const int NT = DM / 128, total = (NTOK / 128) * NT;
        for (int tile = blockIdx.x; tile < total; tile += G) {
            const int mt = tile / NT, nt = tile - mt * NT;
            gemm_tile<EPI_RESID, false>(p.mbuf, DM, nullptr, 0, mt * 128, p.w_out_t, nullptr, DM, nt * 128, p, 0, 0, nullptr, 0, smem);
        }
    } else if (PH == 4) {
        rownorm_phase(p.xbuf, nullptr, nullptr, p.norm_ffn + (size_t)l * DM, p.h, nullptr,
                      moe ? (p.router_w + (size_t)j * DM * NEXP) : nullptr, p.topi, p.topw);
    } else if (PH == 5) {
        const int NT = DFF / 128, total = (NTOK / 128) * NT;
        for (int tile = blockIdx.x; tile < total; tile += G) {
            const int mt = tile / NT, nt = tile - mt * NT;
            gemm_tile<EPI_SWIGLU, true>(p.h, DM, nullptr, 0, mt * 128, p.wf, p.wf + (size_t)DM * DFF, DM, nt * 128, p, DFF, 0, nullptr, 0, smem);
        }
    } else if (PH == 6) {
        const int NT = DM / 128, total = (NTOK / 128) * NT;
        for (int tile = blockIdx.x; tile < total; tile += G) {
            const int mt = tile / NT, nt = tile - mt * NT;
            gemm_tile<EPI_RESID, false>(p.R1, DFF, nullptr, 0, mt * 128, p.wf + (size_t)2 * DM * DFF, nullptr, DFF, nt * 128, p, 0, 0, nullptr, 0, smem);
        }
    } else if (PH == 7) {
        if (blockIdx.x < NEXP) {
            const int e = blockIdx.x; int base = 0;
            for (int it = 0; it < NTOK / 256; ++it) {
                const int tok = it * 256 + tid;
                const int i0 = p.topi[tok * 2], i1 = p.topi[tok * 2 + 1];
                const int sel = (i0 == e) ? 0 : ((i1 == e) ? 1 : -1);
                const unsigned long long bal = __ballot(sel >= 0);
                const int wpos = __popcll(bal & ((1ull << lane) - 1ull));
                if (lane == 0) wsum[wave] = __popcll(bal);
                __syncthreads();
                int off = 0, tot = 0;
#pragma unroll
                for (int w = 0; w < 4; ++w) { const int sv = wsum[w]; if (w < wave) off += sv; tot += sv; }
                if (sel >= 0) p.list[e * NTOK + base + off + wpos] = tok * 2 + sel;
                base += tot;
                __syncthreads();
            }
            if (tid == 0) p.counts[e] = base;
        }
    } else if (PH == 8 || PH == 9) {
        const size_t es = (size_t)NEXP * DM * DFE;
        int tot_mt = 0;
        for (int i = 0; i < NEXP; ++i) tot_mt += (p.counts[i] + 127) >> 7;
        const int NT = (PH == 8) ? (DFE / 128) : (DM / 128);
        const int total = tot_mt * NT;
        for (int tile = blockIdx.x; tile < total; tile += G) {
            const int mtg = tile / NT, nt = tile - mtg * NT;
            int e = 0, start = 0, cnt = 0, a = 0;
            for (int i = 0; i < NEXP; ++i) { const int c = p.counts[i]; const int mt = (c + 127) >> 7; if (mtg >= a && mtg < a + mt) { e = i; start = a; cnt = c; } a += mt; }
            const int ml = mtg - start;
            if (PH == 8)
                gemm_tile<EPI_SWIGLU, true>(p.h, DM, p.list + e * NTOK, cnt, ml * 128,
                                            p.wf + (size_t)e * DM * DFE, p.wf + es + (size_t)e * DM * DFE, DM, nt * 128, p, DFE, start * 128, nullptr, 0, smem);
            else
                gemm_tile<EPI_MOEDOWN, false>(p.R1 + (size_t)start * 128 * DFE, DFE, nullptr, 0, ml * 128,
                                              p.wf + 2 * es + (size_t)e * DM * DFE, nullptr, DFE, nt * 128, p, 0, 0, p.list + e * NTOK, cnt, smem);
        }
    } else {
        rownorm_phase(p.xbuf, p.Y, nullptr, p.norm_final, nullptr, p.out, nullptr, nullptr, nullptr);
    }
}

__global__ void __launch_bounds__(256) trunk_kernel(Params p)
{
    __shared__ __attribute__((aligned(16))) u16 smem[3 * 128 * LDT];
    __shared__ uint4 xb_words;
    __shared__ int wsum[4];
    if (threadIdx.x == 0) xb_words = make_uint4(0u, 0u, 0u, 0u);
    __syncthreads();
    const XcdBarrier bar = xcd_barrier_post(p.bar, (volatile LAS unsigned*)&xb_words);
#pragma unroll 1
    for (int l = 0; l < 4; ++l) {
        run_phase<0>(p, l, smem, wsum); xcd_barrier(bar);
        run_phase<1>(p, l, smem, wsum); xcd_barrier(bar);
        run_phase<2>(p, l, smem, wsum); xcd_barrier(bar);
        run_phase<3>(p, l, smem, wsum); xcd_barrier(bar);
        run_phase<4>(p, l, smem, wsum); xcd_barrier(bar);
        if ((l & 1) == 0) {
            run_phase<5>(p, l, smem, wsum); xcd_barrier(bar);
            run_phase<6>(p, l, smem, wsum); xcd_barrier(bar);
        } else {
            run_phase<7>(p, l, smem, wsum); xcd_barrier(bar);
            run_phase<8>(p, l, smem, wsum); xcd_barrier(bar);
            run_phase<9>(p, l, smem, wsum); xcd_barrier(bar);
        }
    }
    run_phase<10>(p, 0, smem, wsum);
}

extern "C" void kernel_launch(void* const* d_in, const int* in_sizes, int n_in,
                              void* d_out, int out_size, void* d_ws, size_t ws_size,
                              hipStream_t stream)
{
    Params p{};
    p.x = (const float*)d_in[0]; p.norm_mix = (const float*)d_in[1]; p.w_in = (const float*)d_in[2];
    p.conv_w = (const float*)d_in[3]; p.lam_q1 = (const float*)d_in[4]; p.lam_k1 = (const float*)d_in[5];
    p.lam_q2 = (const float*)d_in[6]; p.lam_k2 = (const float*)d_in[7]; p.subln_g = (const float*)d_in[8];
    p.w_out = (const float*)d_in[9]; p.norm_ffn = (const float*)d_in[10]; p.ffn_w_gate = (const float*)d_in[11];
    p.ffn_w_up = (const float*)d_in[12]; p.ffn_w_down = (const float*)d_in[13]; p.router_w = (const float*)d_in[14];
    p.exp_w_gate = (const float*)d_in[15]; p.exp_w_up = (const float*)d_in[16]; p.exp_w_down = (const float*)d_in[17];
    p.norm_final = (const float*)d_in[18];
    p.out = (float*)d_out;
    char* ws = (char*)d_ws; size_t off = 0;
    auto take = [&](size_t bytes) { char* r = ws + off; off += (bytes + 255) & ~(size_t)255; return r; };
    p.bar = (unsigned*)take(16384);
    p.counts = (int*)take(256);
    p.cosT = (float*)take((size_t)SEQ * 32 * 4);
    p.sinT = (float*)take((size_t)SEQ * 32 * 4);
    p.xbuf = (float*)take((size_t)NTOK * DM * 4);
    p.h = (u16*)take((size_t)NTOK * DM * 2);
    p.mbuf = (u16*)take((size_t)NTOK * DM * 2);
    p.Vt = (u16*)take((size_t)NTOK * DM * 2);
    p.topi = (int*)take((size_t)NTOK * 2 * 4);
    p.topw = (float*)take((size_t)NTOK * 2 * 4);
    p.list = (int*)take((size_t)NEXP * NTOK * 4);
    p.R1 = (u16*)take((size_t)NTOK * INW * 2);
    p.Y = (float*)take((size_t)NTOK * 2 * DM * 4);
    p.w_in_t = (u16*)take((size_t)DM * INW * 2);
    p.w_out_t = (u16*)take((size_t)DM * DM * 2);
    p.wf = (u16*)take((size_t)3 * NEXP * DM * DFE * 2);
    if (off > ws_size) { fprintf(stderr, "kernel_launch: workspace too small (%zu > %zu)\n", off, ws_size); return; }

    int dev = 0, cus = 0, per_cu = 0;
    (void)hipGetDevice(&dev);
    (void)hipDeviceGetAttribute(&cus, hipDeviceAttributeMultiprocessorCount, dev);
    if (hipOccupancyMaxActiveBlocksPerMultiprocessor(&per_cu, (const void*)trunk_kernel, 256, 0) != hipSuccess || per_cu < 1) per_cu = 1;
    if (per_cu > 2) per_cu = 2;
    if (cus < 1) cus = 256;
    const int grid = cus * per_cu;
    (void)hipMemsetAsync(p.bar, 0, 16384, stream);
    hipLaunchKernelGGL(trunk_kernel, dim3(grid), dim3(256), 0, stream, p);
}
```

```cpp
#include <hip/hip_runtime.h>
#include <stdint.h>
#include <stdio.h>

typedef unsigned short u16;
using bf16x8 = __attribute__((ext_vector_type(8))) short;
using s16x4  = __attribute__((ext_vector_type(4))) short;
using f32x16 = __attribute__((ext_vector_type(16))) float;

#define MFMA16(a, b, c) __builtin_amdgcn_mfma_f32_32x32x16_bf16((a), (b), (c), 0, 0, 0)
#define MFMA8(a, b, c)  __builtin_amdgcn_mfma_f32_32x32x8bf16_1k((a), (b), (c), 0, 0, 0)

#define NTOK   16384
#define DM     1024
#define SEQ    2048
#define INW    8192
#define DFF    2816
#define DFE    3584
#define NEXP   8

#define XB_TMO      128
#define XB_XCNT(j)  (256  + 64 * (j))
#define XB_XSUB(j)  (1280 + 64 * (j))
#define XB_XGEN(j)  (2304 + 64 * (j))
#define XB_TOP      3328
#define XB_TOPGEN   3392
#define XCD_BAR_WORDS 3456
#define XB_SPIN_CAP (1u << 24)
#define LAS __attribute__((address_space(3)))

__device__ __forceinline__ unsigned xb_ld(unsigned* p)              { return __hip_atomic_load(p, __ATOMIC_RELAXED, __HIP_MEMORY_SCOPE_AGENT); }
__device__ __forceinline__ unsigned xb_add(unsigned* p, unsigned v) { return __hip_atomic_fetch_add(p, v, __ATOMIC_RELAXED, __HIP_MEMORY_SCOPE_AGENT); }
__device__ __forceinline__ unsigned xb_xcc_id() { return (unsigned)__builtin_amdgcn_s_getreg((3 << 11) | 20) & 0xFu; }
#define XB_SPIN(cond, bar) do { unsigned _sp = 0; while (cond) { __builtin_amdgcn_s_sleep(1); \
    if ((++_sp & 255u) == 0u) { if (xb_ld(&(bar)[XB_TMO])) break; if (_sp > XB_SPIN_CAP) { atomicAdd(&(bar)[XB_TMO], 1u); break; } } } } while (0)

struct XcdBarrier { unsigned* bar; unsigned x; volatile LAS unsigned* st; };

__device__ __forceinline__ XcdBarrier xcd_barrier_post(unsigned* bar, volatile LAS unsigned* st) {
    XcdBarrier b; b.bar = bar; b.x = xb_xcc_id(); b.st = st;
    if (threadIdx.x == 0) (void)xb_add(&bar[XB_XCNT(b.x)], 1u);
    return b;
}
__device__ __forceinline__ void xcd_barrier_complete(unsigned* bar, unsigned x, unsigned& nloc, unsigned& nx) {
    const unsigned G = gridDim.x * gridDim.y * gridDim.z;
    unsigned sum, cnt, mine, sp = 0u;
    for (;;) {
        sum = 0u; cnt = 0u; mine = 0u;
#pragma unroll
        for (unsigned j = 0; j < 16; ++j) { const unsigned c = xb_ld(&bar[XB_XCNT(j)]); sum += c; cnt += (c > 0u) ? 1u : 0u; mine = (j == x) ? c : mine; }
        if (sum == G) break;
        __builtin_amdgcn_s_sleep(1);
        if ((++sp & 255u) == 0u) { if (xb_ld(&bar[XB_TMO])) break; if (sp > XB_SPIN_CAP) { atomicAdd(&bar[XB_TMO], 1u); break; } }
    }
    nloc = mine > 0u ? mine : 1u; nx = cnt > 0u ? cnt : 1u;
}
__device__ __forceinline__ void xcd_barrier(const XcdBarrier b) {
    asm volatile("s_waitcnt vmcnt(0)" ::: "memory");
    __syncthreads();
    if (threadIdx.x == 0) {
        unsigned* bar = b.bar;
        __builtin_amdgcn_s_waitcnt(0);
        unsigned nloc = b.st[0], nx = b.st[1];
        if (nloc == 0u) { xcd_barrier_complete(bar, b.x, nloc, nx); b.st[0] = nloc; b.st[1] = nx; }
        const unsigned old = xb_add(&bar[XB_XSUB(b.x)], 1u);
        const unsigned gen = old / nloc;
        if (old + 1u == (gen + 1u) * nloc) {
            __builtin_amdgcn_fence(__ATOMIC_RELEASE, "agent");
            asm volatile("s_waitcnt vmcnt(0)" ::: "memory");
            const unsigned og = xb_add(&bar[XB_TOP], 1u);
            const unsigned tg = og / nx;
            if (og + 1u == (tg + 1u) * nx) xb_add(&bar[XB_TOPGEN], 1u);
            else XB_SPIN(xb_ld(&bar[XB_TOPGEN]) == tg, bar);
            __builtin_amdgcn_fence(__ATOMIC_ACQUIRE, "agent");
            xb_add(&bar[XB_XGEN(b.x)], 1u);
            asm volatile("s_waitcnt vmcnt(0)" ::: "memory");
        } else {
            XB_SPIN(xb_ld(&bar[XB_XGEN(b.x)]) == gen, bar);
            __builtin_amdgcn_fence(__ATOMIC_ACQUIRE, "agent");
            asm volatile("s_waitcnt vmcnt(0)" ::: "memory");
        }
    }
    __syncthreads();
}

__device__ __forceinline__ u16 f2bf(float f) {
    uint32_t u = __float_as_uint(f);
    u += 0x7fffu + ((u >> 16) & 1u);
    return (u16)(u >> 16);
}
__device__ __forceinline__ float bf2f(u16 h) { return __uint_as_float(((uint32_t)h) << 16); }
__device__ __forceinline__ float sigm(float x) { return 1.0f / (1.0f + __expf(-x)); }
__device__ __forceinline__ float wave_sum(float v) {
#pragma unroll
    for (int o = 32; o >= 1; o >>= 1) v += __shfl_xor(v, o);
    return v;
}

struct Params {
    const float *x, *norm_mix, *w_in, *conv_w, *lam_q1, *lam_k1, *lam_q2, *lam_k2, *subln_g, *w_out, *norm_ffn;
    const float *ffn_w_gate, *ffn_w_up, *ffn_w_down, *router_w, *exp_w_gate, *exp_w_up, *exp_w_down, *norm_final;
    float* out;
    unsigned* bar;
    int* counts;
    float* cosT;
    float* sinT;
    float* xbuf;
    u16* h;
    u16* mbuf;
    u16* Vt;
    int* topi;
    float* topw;
    int* list;
    u16* R1;
    float* Y;
    u16* w_in_t;
    u16* w_out_t;
    u16* wf;
};

struct EpiArgs {
    u16* proj; u16* Vt; const float* cosT; const float* sinT;
    float* xbuf;
    u16* H; int ldh; int orow_off;
    float* Y; const float* topw; const int* rowlist; int mvalid;
};

enum { EPI_INPROJ = 0, EPI_RESID = 1, EPI_SWIGLU = 2, EPI_MOEDOWN = 3 };

#define LDT 72

template <int EPI, bool DUAL>
__device__ __forceinline__ void gemm_tile(const u16* __restrict__ A, int lda, const int* __restrict__ gather, int mvalid, int m0,
                                          const u16* __restrict__ B0, const u16* __restrict__ B1, int K, int n0,
                                          const Params& p, int e_ldh, int e_orow, const int* e_rowlist, int e_mvalid, u16* smem)
{
    u16* As = smem; u16* Bs0 = smem + 128 * LDT; u16* Bs1 = smem + 2 * 128 * LDT;
    const int tid = threadIdx.x, lane = tid & 63, wave = tid >> 6;
    const int wm = (wave >> 1) * 64, wn = (wave & 1) * 64;
    const int l32 = lane & 31, half = lane >> 5;

    const int row0 = tid >> 3, sg8 = (tid & 7) * 8;
    int ar0 = m0 + row0, ar1 = ar0 + 32, ar2 = ar0 + 64, ar3 = ar0 + 96;
    if (gather) {
        ar0 = (ar0 < mvalid) ? (gather[ar0] >> 1) : 0; ar1 = (ar1 < mvalid) ? (gather[ar1] >> 1) : 0;
        ar2 = (ar2 < mvalid) ? (gather[ar2] >> 1) : 0; ar3 = (ar3 < mvalid) ? (gather[ar3] >> 1) : 0;
    }
    const u16* ap0 = A + (size_t)ar0 * lda + sg8;
    const u16* ap1 = A + (size_t)ar1 * lda + sg8;
    const u16* ap2 = A + (size_t)ar2 * lda + sg8;
    const u16* ap3 = A + (size_t)ar3 * lda + sg8;
    const u16* bpa = B0 + (size_t)(n0 + row0) * K + sg8;
    const u16* bpb = DUAL ? (B1 + (size_t)(n0 + row0) * K + sg8) : bpa;
    const size_t bst = (size_t)32 * K;
    const int so0 = row0 * LDT + sg8;
    const int sst = 32 * LDT;
    f32x16 acc[DUAL ? 2 : 1][2][2];
#pragma unroll
    for (int d = 0; d < (DUAL ? 2 : 1); ++d)
#pragma unroll
        for (int i = 0; i < 2; ++i)
#pragma unroll
            for (int j = 0; j < 2; ++j)
#pragma unroll
                for (int r = 0; r < 16; ++r) acc[d][i][j][r] = 0.f;

    uint4 ra0 = *(const uint4*)ap0, ra1 = *(const uint4*)ap1, ra2 = *(const uint4*)ap2, ra3 = *(const uint4*)ap3;
    uint4 rba0 = *(const uint4*)bpa, rba1 = *(const uint4*)(bpa + bst), rba2 = *(const uint4*)(bpa + 2 * bst), rba3 = *(const uint4*)(bpa + 3 * bst);
    uint4 rbb0 = rba0, rbb1 = rba1, rbb2 = rba2, rbb3 = rba3;
    if (DUAL) { rbb0 = *(const uint4*)bpb; rbb1 = *(const uint4*)(bpb + bst); rbb2 = *(const uint4*)(bpb + 2 * bst); rbb3 = *(const uint4*)(bpb + 3 * bst); }
    const int nk = K >> 6;
    for (int kt = 0; kt < nk; ++kt) {
        __syncthreads();
        *(uint4*)(As + so0) = ra0; *(uint4*)(As + so0 + sst) = ra1; *(uint4*)(As + so0 + 2 * sst) = ra2; *(uint4*)(As + so0 + 3 * sst) = ra3;
        *(uint4*)(Bs0 + so0) = rba0; *(uint4*)(Bs0 + so0 + sst) = rba1; *(uint4*)(Bs0 + so0 + 2 * sst) = rba2; *(uint4*)(Bs0 + so0 + 3 * sst) = rba3;
        if (DUAL) { *(uint4*)(Bs1 + so0) = rbb0; *(uint4*)(Bs1 + so0 + sst) = rbb1; *(uint4*)(Bs1 + so0 + 2 * sst) = rbb2; *(uint4*)(Bs1 + so0 + 3 * sst) = rbb3; }
        __syncthreads();
        if (kt + 1 < nk) {
            const int ko = (kt + 1) * 64;
            ra0 = *(const uint4*)(ap0 + ko); ra1 = *(const uint4*)(ap1 + ko); ra2 = *(const uint4*)(ap2 + ko); ra3 = *(const uint4*)(ap3 + ko);
            rba0 = *(const uint4*)(bpa + ko); rba1 = *(const uint4*)(bpa + bst + ko); rba2 = *(const uint4*)(bpa + 2 * bst + ko); rba3 = *(const uint4*)(bpa + 3 * bst + ko);
            if (DUAL) { rbb0 = *(const uint4*)(bpb + ko); rbb1 = *(const uint4*)(bpb + bst + ko); rbb2 = *(const uint4*)(bpb + 2 * bst + ko); rbb3 = *(const uint4*)(bpb + 3 * bst + ko); }
        }
#pragma unroll
        for (int ks = 0; ks < 4; ++ks) {
            bf16x8 af[2], bf[2], bg[2];
#pragma unroll
            for (int i = 0; i < 2; ++i) af[i] = *(const bf16x8*)(As + (wm + i * 32 + l32) * LDT + ks * 16 + half * 8);
#pragma unroll
            for (int j = 0; j < 2; ++j) {
                bf[j] = *(const bf16x8*)(Bs0 + (wn + j * 32 + l32) * LDT + ks * 16 + half * 8);
                if (DUAL) bg[j] = *(const bf16x8*)(Bs1 + (wn + j * 32 + l32) * LDT + ks * 16 + half * 8);
            }
#pragma unroll
            for (int i = 0; i < 2; ++i)
#pragma unroll
                for (int j = 0; j < 2; ++j) {
                    acc[0][i][j] = MFMA16(af[i], bf[j], acc[0][i][j]);
                    if (DUAL) acc[DUAL ? 1 : 0][i][j] = MFMA16(af[i], bg[j], acc[DUAL ? 1 : 0][i][j]);
                }
        }
    }

    if (EPI == EPI_INPROJ) {
        const int seg = n0 >> 10;
        if (seg < 2) {
            const float qs = (seg == 0) ? 0.125f : 1.0f;
#pragma unroll
            for (int i = 0; i < 2; ++i)
#pragma unroll
                for (int r = 0; r < 16; ++r) {
                    const int m = m0 + wm + i * 32 + (r >> 2) * 8 + half * 4 + (r & 3);
                    const int pos = m & (SEQ - 1);
                    const float c = p.cosT[pos * 32 + l32], s = p.sinT[pos * 32 + l32];
                    const float x1 = acc[0][i][0][r], x2 = acc[0][i][1][r];
                    const float o1 = (x1 * c - x2 * s) * qs, o2 = (x2 * c + x1 * s) * qs;
                    u16* dst = p.R1 + (size_t)m * INW + n0 + wn + l32;
                    dst[0] = f2bf(o1); dst[32] = f2bf(o2);
                }
        } else if (seg == 2) {
#pragma unroll
            for (int i = 0; i < 2; ++i)
#pragma unroll
                for (int j = 0; j < 2; ++j)
#pragma unroll
                    for (int rq = 0; rq < 4; ++rq) {
                        const int m = m0 + wm + i * 32 + rq * 8 + half * 4;
                        const int b = m >> 11, t = m & (SEQ - 1);
                        const int nn = n0 - 2048 + wn + j * 32 + l32;
                        ushort4 v;
                        v.x = f2bf(acc[0][i][j][rq * 4 + 0]); v.y = f2bf(acc[0][i][j][rq * 4 + 1]);
                        v.z = f2bf(acc[0][i][j][rq * 4 + 2]); v.w = f2bf(acc[0][i][j][rq * 4 + 3]);
                        *(ushort4*)(p.Vt + ((size_t)(b * 1024 + nn)) * SEQ + t) = v;
                    }
        } else {
#pragma unroll
            for (int i = 0; i < 2; ++i)
#pragma unroll
                for (int j = 0; j < 2; ++j)
#pragma unroll
                    for (int r = 0; r < 16; ++r) {
                        const int m = m0 + wm + i * 32 + (r >> 2) * 8 + half * 4 + (r & 3);
                        p.R1[(size_t)m * INW + n0 + wn + j * 32 + l32] = f2bf(acc[0][i][j][r]);
                    }
        }
    } else if (EPI == EPI_RESID) {
#pragma unroll
        for (int i = 0; i < 2; ++i)
#pragma unroll
            for (int j = 0; j < 2; ++j)
#pragma unroll
                for (int r = 0; r < 16; ++r) {
                    const int m = m0 + wm + i * 32 + (r >> 2) * 8 + half * 4 + (r & 3);
                    float* xp = p.xbuf + (size_t)m * DM + n0 + wn + j * 32 + l32;
                    *xp = *xp + acc[0][i][j][r];
                }
    } else if (EPI == EPI_SWIGLU) {
#pragma unroll
        for (int i = 0; i < 2; ++i)
#pragma unroll
            for (int j = 0; j < 2; ++j)
#pragma unroll
                for (int r = 0; r < 16; ++r) {
                    const int m = m0 + wm + i * 32 + (r >> 2) * 8 + half * 4 + (r & 3) + e_orow;
                    const float g = acc[0][i][j][r], u = acc[DUAL ? 1 : 0][i][j][r];
                    p.R1[(size_t)m * e_ldh + n0 + wn + j * 32 + l32] = f2bf(g * sigm(g) * u);
                }
    } else {
#pragma unroll
        for (int i = 0; i < 2; ++i)
#pragma unroll
            for (int r = 0; r < 16; ++r) {
                const int lm = m0 + wm + i * 32 + (r >> 2) * 8 + half * 4 + (r & 3);
                if (lm < e_mvalid) {
                    const int ent = e_rowlist[lm];
                    const float w = p.topw[ent];
#pragma unroll
                    for (int j = 0; j < 2; ++j)
                        p.Y[(size_t)ent * DM + n0 + wn + j * 32 + l32] = w * acc[0][i][j][r];
                }
            }
    }
}

__device__ void convert_job(const float* __restrict__ src, u16* __restrict__ dst, int K, int N, int batch, u16* T)
{
    const int tid = threadIdx.x;
    const int tk = K >> 6, tn = N >> 6; const int per = tk * tn; const int total = per * batch;
    for (int tile = blockIdx.x; tile < total; tile += gridDim.x) {
        const int bi = tile / per; const int r = tile - bi * per; const int kt = r / tn, nt = r - kt * tn;
        const float* s = src + (size_t)bi * K * N + (size_t)(kt * 64) * N + nt * 64;
        u16* d = dst + (size_t)bi * K * N + (size_t)(nt * 64) * K + kt * 64;
        __syncthreads();
#pragma unroll
        for (int i = 0; i < 4; ++i) {
            const int k = (tid >> 4) + 16 * i; const int n4 = (tid & 15) * 4;
            const float4 v = *(const float4*)(s + (size_t)k * N + n4);
            T[(n4 + 0) * 72 + k] = f2bf(v.x); T[(n4 + 1) * 72 + k] = f2bf(v.y);
            T[(n4 + 2) * 72 + k] = f2bf(v.z); T[(n4 + 3) * 72 + k] = f2bf(v.w);
        }
        __syncthreads();
#pragma unroll
        for (int i = 0; i < 2; ++i) {
            const int c = tid + 256 * i; const int n = c >> 3, seg = c & 7;
            const uint4 v = *(const uint4*)(T + n * 72 + seg * 8);
            *(uint4*)(d + (size_t)n * K + seg * 8) = v;
        }
    }
}

__device__ void rownorm_phase(const float* __restrict__ xsrc, const float* __restrict__ Y, float* __restrict__ xdst,
                              const float* __restrict__ g, u16* __restrict__ hout, float* __restrict__ fout,
                              const float* __restrict__ router, int* __restrict__ topi, float* __restrict__ topw)
{
    const int lane = threadIdx.x & 63, wave = threadIdx.x >> 6;
    for (int row = blockIdx.x * 4 + wave; row < NTOK; row += gridDim.x * 4) {
        float4 v[4]; float ss = 0.f;
#pragma unroll
        for (int i = 0; i < 4; ++i) {
            const int d = i * 256 + lane * 4;
            v[i] = *(const float4*)(xsrc + (size_t)row * DM + d);
            if (Y) {
                const float4 y0 = *(const float4*)(Y + (size_t)(row * 2) * DM + d);
                const float4 y1 = *(const float4*)(Y + (size_t)(row * 2 + 1) * DM + d);
                v[i].x += y0.x + y1.x; v[i].y += y0.y + y1.y; v[i].z += y0.z + y1.z; v[i].w += y0.w + y1.w;
            }
            if (xdst) *(float4*)(xdst + (size_t)row * DM + d) = v[i];
            ss += v[i].x * v[i].x + v[i].y * v[i].y + v[i].z * v[i].z + v[i].w * v[i].w;
        }
        ss = wave_sum(ss);
        const float rs = rsqrtf(ss * (1.0f / DM) + 1e-5f);
        float lg[8];
#pragma unroll
        for (int e = 0; e < 8; ++e) lg[e] = 0.f;
#pragma unroll
        for (int i = 0; i < 4; ++i) {
            const int d = i * 256 + lane * 4;
            const float4 gv = *(const float4*)(g + d);
            float4 y; y.x = v[i].x * rs * gv.x; y.y = v[i].y * rs * gv.y; y.z = v[i].z * rs * gv.z; y.w = v[i].w * rs * gv.w;
            if (hout) {
                ushort4 o; o.x = f2bf(y.x); o.y = f2bf(y.y); o.z = f2bf(y.z); o.w = f2bf(y.w);
                *(ushort4*)(hout + (size_t)row * DM + d) = o;
            }
            if (fout) *(float4*)(fout + (size_t)row * DM + d) = y;
            if (router) {
                const float yy[4] = {y.x, y.y, y.z, y.w};
#pragma unroll
                for (int jj = 0; jj < 4; ++jj) {
                    const float4 r0 = *(const float4*)(router + (size_t)(d + jj) * 8);
                    const float4 r1 = *(const float4*)(router + (size_t)(d + jj) * 8 + 4);
                    lg[0] += yy[jj] * r0.x; lg[1] += yy[jj] * r0.y; lg[2] += yy[jj] * r0.z; lg[3] += yy[jj] * r0.w;
                    lg[4] += yy[jj] * r1.x; lg[5] += yy[jj] * r1.y; lg[6] += yy[jj] * r1.z; lg[7] += yy[jj] * r1.w;
                }
            }
        }
        if (router) {
#pragma unroll
            for (int e = 0; e < 8; ++e) lg[e] = wave_sum(lg[e]);
            float b0 = lg[0]; int i0 = 0;
#pragma unroll
            for (int e = 1; e < 8; ++e) if (lg[e] > b0) { b0 = lg[e]; i0 = e; }
            float b1 = -3.0e38f; int i1 = 0;
#pragma unroll
            for (int e = 0; e < 8; ++e) if (e != i0 && lg[e] > b1) { b1 = lg[e]; i1 = e; }
            const float w0 = 1.0f / (1.0f + __expf(b1 - b0));
            if (lane == 0) {
                topi[row * 2] = i0; topi[row * 2 + 1] = i1;
                topw[row * 2] = w0; topw[row * 2 + 1] = 1.0f - w0;
            }
        }
    }
}

__device__ void attn_unit(const Params& p, int l, int b, int hh, int qb, float lam, float lam_init, u16* smem)
{
    u16* Ks = smem;
    u16* Vs = smem + 64 * 72;
    const int tid = threadIdx.x, lane = tid & 63, wave = tid >> 6;
    const int l32 = lane & 31, half = lane >> 5;
    const int q0 = qb * 128 + wave * 32;
    const int tq = q0 + l32;
    const u16* proj = p.R1;
    const size_t rowq = (size_t)(b * SEQ + tq) * INW;
    const int nkv = (qb * 128 + 128) >> 6;

    f32x16 res[4];
#pragma unroll 1
    for (int map = 0; map < 2; ++map) {
        bf16x8 qf[4];
#pragma unroll
        for (int ks = 0; ks < 4; ++ks) qf[ks] = *(const bf16x8*)(proj + rowq + (2 * hh + map) * 64 + ks * 16 + half * 8);
        float m_i = -1.0e30f, l_i = 0.f;
        f32x16 acc[4];
#pragma unroll
        for (int et = 0; et < 4; ++et)
#pragma unroll
            for (int r = 0; r < 16; ++r) acc[et][r] = 0.f;

        for (int kt = 0; kt < nkv; ++kt) {
            const int key0 = kt * 64;
            __syncthreads();
#pragma unroll
            for (int i = 0; i < 2; ++i) {
                const int c = tid + 256 * i; const int row = c >> 3, seg = c & 7;
                *(uint4*)(Ks + row * 72 + seg * 8) =
                    *(const uint4*)(proj + (size_t)(b * SEQ + key0 + row) * INW + 1024 + (2 * hh + map) * 64 + seg * 8);
            }
#pragma unroll
            for (int i = 0; i < 4; ++i) {
                const int c = tid + 256 * i; const int row = c >> 3, seg = c & 7;
                *(uint4*)(Vs + row * 72 + seg * 8) =
                    *(const uint4*)(p.Vt + ((size_t)((b * 8 + hh) * 128 + row)) * SEQ + key0 + seg * 8);
            }
            __syncthreads();
            if (key0 <= q0 + 31) {
                f32x16 st[2];
#pragma unroll
                for (int kb = 0; kb < 2; ++kb) {
#pragma unroll
                    for (int r = 0; r < 16; ++r) st[kb][r] = 0.f;
#pragma unroll
                    for (int ks = 0; ks < 4; ++ks) {
                        const bf16x8 kf = *(const bf16x8*)(Ks + (kb * 32 + l32) * 72 + ks * 16 + half * 8);
                        st[kb] = MFMA16(kf, qf[ks], st[kb]);
                    }
                }
                float mx = -1.0e30f;
#pragma unroll
                for (int kb = 0; kb < 2; ++kb)
#pragma unroll
                    for (int r = 0; r < 16; ++r) {
                        const int key = key0 + kb * 32 + (r >> 2) * 8 + half * 4 + (r & 3);
                        if (key > tq) st[kb][r] = -1.0e30f;
                        mx = fmaxf(mx, st[kb][r]);
                    }
                mx = fmaxf(mx, __shfl_xor(mx, 32));
                const float mnew = fmaxf(m_i, mx);
                const float alpha = __expf(m_i - mnew);
                float rsum = 0.f;
#pragma unroll
                for (int kb = 0; kb < 2; ++kb)
#pragma unroll
                    for (int r = 0; r < 16; ++r) { const float e = __expf(st[kb][r] - mnew); st[kb][r] = e; rsum += e; }
                rsum += __shfl_xor(rsum, 32);
                l_i = l_i * alpha + rsum; m_i = mnew;
#pragma unroll
                for (int et = 0; et < 4; ++et)
#pragma unroll
                    for (int r = 0; r < 16; ++r) acc[et][r] *= alpha;
#pragma unroll
                for (int kb = 0; kb < 2; ++kb)
#pragma unroll
                    for (int kk = 0; kk < 4; ++kk) {
                        s16x4 pb;
                        pb[0] = (short)f2bf(st[kb][kk * 4 + 0]); pb[1] = (short)f2bf(st[kb][kk * 4 + 1]);
                        pb[2] = (short)f2bf(st[kb][kk * 4 + 2]); pb[3] = (short)f2bf(st[kb][kk * 4 + 3]);
#pragma unroll
                        for (int et = 0; et < 4; ++et) {
                            const s16x4 vf = *(const s16x4*)(Vs + (et * 32 + l32) * 72 + kb * 32 + kk * 8 + half * 4);
                            acc[et] = MFMA8(vf, pb, acc[et]);
                        }
                    }
            }
        }
        const float inv = 1.0f / l_i;
        float* tmp = p.Y + (size_t)(b * SEQ + tq) * DM + hh * 128;
        if (map == 0) {
#pragma unroll
            for (int et = 0; et < 4; ++et)
#pragma unroll
                for (int rq = 0; rq < 4; ++rq) {
                    float4 v; v.x = acc[et][rq * 4 + 0] * inv; v.y = acc[et][rq * 4 + 1] * inv;
                    v.z = acc[et][rq * 4 + 2] * inv; v.w = acc[et][rq * 4 + 3] * inv;
                    *(float4*)(tmp + et * 32 + rq * 8 + half * 4) = v;
                }
        } else {
            const float li = lam * inv;
#pragma unroll
            for (int et = 0; et < 4; ++et)
#pragma unroll
                for (int rq = 0; rq < 4; ++rq) {
                    const float4 v = *(const float4*)(tmp + et * 32 + rq * 8 + half * 4);
                    res[et][rq * 4 + 0] = v.x - acc[et][rq * 4 + 0] * li; res[et][rq * 4 + 1] = v.y - acc[et][rq * 4 + 1] * li;
                    res[et][rq * 4 + 2] = v.z - acc[et][rq * 4 + 2] * li; res[et][rq * 4 + 3] = v.w - acc[et][rq * 4 + 3] * li;
                }
        }
    }
    float ss = 0.f;
#pragma unroll
    for (int et = 0; et < 4; ++et)
#pragma unroll
        for (int r = 0; r < 16; ++r) ss += res[et][r] * res[et][r];
    ss += __shfl_xor(ss, 32);
    const float rs = rsqrtf(ss * (1.0f / 128.0f) + 1e-5f) * (1.0f - lam_init);
    float* tmp2 = p.Y + (size_t)(b * SEQ + tq) * DM + hh * 128;
#pragma unroll
    for (int et = 0; et < 4; ++et)
#pragma unroll
        for (int rq = 0; rq < 4; ++rq) {
            float4 v; v.x = res[et][rq * 4 + 0] * rs; v.y = res[et][rq * 4 + 1] * rs;
            v.z = res[et][rq * 4 + 2] * rs; v.w = res[et][rq * 4 + 3] * rs;
            *(float4*)(tmp2 + et * 32 + rq * 8 + half * 4) = v;
        }
    const float* cw = p.conv_w + (size_t)l * 3 * DM;
    const float* sg = p.subln_g + (size_t)l * 128;
    const u16* r0p = proj + rowq;
    const u16* r1p = proj + rowq - INW;
    const u16* r2p = proj + rowq - 2 * INW;
    const bool h1 = tq >= 1, h2 = tq >= 2;
#pragma unroll 1
    for (int gi = 0; gi < 16; ++gi) {
        const int e4 = (gi >> 2) * 32 + (gi & 3) * 8 + half * 4;
        const int ch = hh * 128 + e4;
        const float4 yv = *(const float4*)(tmp2 + e4);
        const ushort4 bg = *(const ushort4*)(r0p + 3072 + ch);
        const ushort4 c0 = *(const ushort4*)(r0p + 4096 + ch);
        const ushort4 u0 = *(const ushort4*)(r0p + 5120 + ch);
        const ushort4 ga = *(const ushort4*)(r0p + 6144 + ch);
        const ushort4 gc = *(const ushort4*)(r0p + 7168 + ch);
        ushort4 c1 = make_ushort4(0, 0, 0, 0), u1 = c1, c2 = c1, u2 = c1;
        if (h1) { c1 = *(const ushort4*)(r1p + 4096 + ch); u1 = *(const ushort4*)(r1p + 5120 + ch); }
        if (h2) { c2 = *(const ushort4*)(r2p + 4096 + ch); u2 = *(const ushort4*)(r2p + 5120 + ch); }
        const float4 w0 = *(const float4*)(cw + ch);
        const float4 w1 = *(const float4*)(cw + DM + ch);
        const float4 w2 = *(const float4*)(cw + 2 * DM + ch);
        const float4 sgv = *(const float4*)(sg + e4);
        ushort4 o;
        {
            const float ya = yv.x * sgv.x;
            const float cv = w0.x * bf2f(c2.x) * bf2f(u2.x) + w1.x * bf2f(c1.x) * bf2f(u1.x) + w2.x * bf2f(c0.x) * bf2f(u0.x);
            o.x = f2bf(sigm(bf2f(ga.x)) * ya + sigm(bf2f(gc.x)) * bf2f(bg.x) * cv);
        }
        {
            const float ya = yv.y * sgv.y;
            const float cv = w0.y * bf2f(c2.y) * bf2f(u2.y) + w1.y * bf2f(c1.y) * bf2f(u1.y) + w2.y * bf2f(c0.y) * bf2f(u0.y);
            o.y = f2bf(sigm(bf2f(ga.y)) * ya + sigm(bf2f(gc.y)) * bf2f(bg.y) * cv);
        }
        {
            const float ya = yv.z * sgv.z;
            const float cv = w0.z * bf2f(c2.z) * bf2f(u2.z) + w1.z * bf2f(c1.z) * bf2f(u1.z) + w2.z * bf2f(c0.z) * bf2f(u0.z);
            o.z = f2bf(sigm(bf2f(ga.z)) * ya + sigm(bf2f(gc.z)) * bf2f(bg.z) * cv);
        }
        {
            const float ya = yv.w * sgv.w;
            const float cv = w0.w * bf2f(c2.w) * bf2f(u2.w) + w1.w * bf2f(c1.w) * bf2f(u1.w) + w2.w * bf2f(c0.w) * bf2f(u0.w);
            o.w = f2bf(sigm(bf2f(ga.w)) * ya + sigm(bf2f(gc.w)) * bf2f(bg.w) * cv);
        }
        *(ushort4*)(p.mbuf + (size_t)(b * SEQ + tq) * DM + ch) = o;
    }
}

template <int PH>
__device__ __forceinline__ void run_phase(const Params& p, int l, u16* smem, int* wsum)
{
    const int tid = threadIdx.x, lane = tid & 63, wave = tid >> 6;
    const int G = gridDim.x;
    const int j = l >> 1; const bool moe = (l & 1);

    if (PH == 0) {
        if (l == 0) {
            for (int idx = blockIdx.x * 256 + tid; idx < SEQ * 32; idx += G * 256) {
                const int pos = idx >> 5, jj = idx & 31;
                const float inv = exp2f(-(float)jj * (13.287712379549449f / 32.0f));
                const float ang = (float)pos * inv;
                double rev = (double)ang * 0.15915494309189535;
                rev -= rint(rev);
                p.cosT[idx] = __builtin_amdgcn_cosf((float)rev);
                p.sinT[idx] = __builtin_amdgcn_sinf((float)rev);
            }
        }
        convert_job(p.w_in + (size_t)l * DM * INW, p.w_in_t, DM, INW, 1, smem);
        convert_job(p.w_out + (size_t)l * DM * DM, p.w_out_t, DM, DM, 1, smem);
        if (!moe) {
            convert_job(p.ffn_w_gate + (size_t)j * DM * DFF, p.wf, DM, DFF, 1, smem);
            convert_job(p.ffn_w_up + (size_t)j * DM * DFF, p.wf + (size_t)DM * DFF, DM, DFF, 1, smem);
            convert_job(p.ffn_w_down + (size_t)j * DM * DFF, p.wf + (size_t)2 * DM * DFF, DFF, DM, 1, smem);
        } else {
            const size_t es = (size_t)NEXP * DM * DFE;
            convert_job(p.exp_w_gate + (size_t)j * es, p.wf, DM, DFE, NEXP, smem);
            convert_job(p.exp_w_up + (size_t)j * es, p.wf + es, DM, DFE, NEXP, smem);
            convert_job(p.exp_w_down + (size_t)j * es, p.wf + 2 * es, DFE, DM, NEXP, smem);
        }
        rownorm_phase(l == 0 ? p.x : p.xbuf, (l > 0 && ((l - 1) & 1)) ? p.Y : nullptr, p.xbuf,
                      p.norm_mix + (size_t)l * DM, p.h, nullptr, nullptr, nullptr, nullptr);
    } else if (PH == 1) {
        const int NT = INW / 128, total = (NTOK / 128) * NT;
        for (int tile = blockIdx.x; tile < total; tile += G) {
            const int mt = tile / NT, nt = tile - mt * NT;
            gemm_tile<EPI_INPROJ, false>(p.h, DM, nullptr, 0, mt * 128, p.w_in_t, nullptr, DM, nt * 128, p, 0, 0, nullptr, 0, smem);
        }
    } else if (PH == 2) {
        const float lam_init = 0.8f - 0.6f * expf(-0.3f * (float)l);
        float d1 = p.lam_q1[l * 64 + lane] * p.lam_k1[l * 64 + lane];
        float d2 = p.lam_q2[l * 64 + lane] * p.lam_k2[l * 64 + lane];
        d1 = wave_sum(d1); d2 = wave_sum(d2);
        const float lam = expf(d1) - expf(d2) + lam_init;
        for (int u = blockIdx.x; u < 1024; u += G) {
            const int qb = 15 - (u >> 6); const int bh = u & 63;
            attn_unit(p, l, bh >> 3, bh & 7, qb, lam, lam_init, smem);
        }
    } else if (PH == 3) {
        const int NT = DM / 128, total = (NTOK / 128) * NT;
        for (int tile = blockIdx.x; tile < total; tile += G) {
            const int mt = ((tile >> 3) / NT) * 8 + (tile & 7), nt = (tile >> 3) % NT;
            gemm_tile<EPI_RESID, false>(p.mbuf, DM, nullptr, 0, mt * 128, p.w_out_t, nullptr, DM, nt * 128, p, 0, 0, nullptr, 0, smem);
        }
    } else if (PH == 4) {
        rownorm_phase(p.xbuf, nullptr, nullptr, p.norm_ffn + (size_t)l * DM, p.h, nullptr,
                      moe ? (p.router_w + (size_t)j * DM * NEXP) : nullptr, p.topi, p.topw);
    } else if (PH == 5) {
        const int NT = DFF / 128, total = (NTOK / 128) * NT;
        for (int tile = blockIdx.x; tile < total; tile += G) {
            const int mt = tile / NT, nt = tile - mt * NT;
            gemm_tile<EPI_SWIGLU, true>(p.h, DM, nullptr, 0, mt * 128, p.wf, p.wf + (size_t)DM * DFF, DM, nt * 128, p, DFF, 0, nullptr, 0, smem);
        }
    } else if (PH == 6) {
        const int NT = DM / 128, total = (NTOK / 128) * NT;
        for (int tile = blockIdx.x; tile < total; tile += G) {
            const int mt = ((tile >> 3) / NT) * 8 + (tile & 7), nt = (tile >> 3) % NT;
            gemm_tile<EPI_RESID, false>(p.R1, DFF, nullptr, 0, mt * 128, p.wf + (size_t)2 * DM * DFF, nullptr, DFF, nt * 128, p, 0, 0, nullptr, 0, smem);
        }
    } else if (PH == 7) {
        if (blockIdx.x < NEXP) {
            const int e = blockIdx.x; int base = 0;
            for (int it = 0; it < NTOK / 256; ++it) {
                const int tok = it * 256 + tid;
                const int i0 = p.topi[tok * 2], i1 = p.topi[tok * 2 + 1];
                const int sel = (i0 == e) ? 0 : ((i1 == e) ? 1 : -1);
                const unsigned long long bal = __ballot(sel >= 0);
                const int wpos = __popcll(bal & ((1ull << lane) - 1ull));
                if (lane == 0) wsum[wave] = __popcll(bal);
                __syncthreads();
                int off = 0, tot = 0;
#pragma unroll
                for (int w = 0; w < 4; ++w) { const int sv = wsum[w]; if (w < wave) off += sv; tot += sv; }
                if (sel >= 0) p.list[e * NTOK + base + off + wpos] = tok * 2 + sel;
                base += tot;
                __syncthreads();
            }
            if (tid == 0) p.counts[e] = base;
        }
    } else if (PH == 8 || PH == 9) {
        const size_t es = (size_t)NEXP * DM * DFE;
        int tot_mt = 0;
        for (int i = 0; i < NEXP; ++i) tot_mt += (p.counts[i] + 127) >> 7;
        const int NT = (PH == 8) ? (DFE / 128) : (DM / 128);
        const int total = (PH == 8) ? (tot_mt * NT) : (((tot_mt + 7) & ~7) * NT);
        for (int tile = blockIdx.x; tile < total; tile += G) {
            const int mtg = (PH == 8) ? (tile / NT) : (((tile >> 3) / NT) * 8 + (tile & 7));
            const int nt = (PH == 8) ? (tile - mtg * NT) : ((tile >> 3) % NT);
            if (mtg >= tot_mt) continue;
            int e = 0, start = 0, cnt = 0, a = 0;
            for (int i = 0; i < NEXP; ++i) { const int c = p.counts[i]; const int mt = (c + 127) >> 7; if (mtg >= a && mtg < a + mt) { e = i; start = a; cnt = c; } a += mt; }
            const int ml = mtg - start;
            if (PH == 8)
                gemm_tile<EPI_SWIGLU, true>(p.h, DM, p.list + e * NTOK, cnt, ml * 128,
                                            p.wf + (size_t)e * DM * DFE, p.wf + es + (size_t)e * DM * DFE, DM, nt * 128, p, DFE, start * 128, nullptr, 0, smem);
            else
                gemm_tile<EPI_MOEDOWN, false>(p.R1 + (size_t)start * 128 * DFE, DFE, nullptr, 0, ml * 128,
                                              p.wf + 2 * es + (size_t)e * DM * DFE, nullptr, DFE, nt * 128, p, 0, 0, p.list + e * NTOK, cnt, smem);
        }
    } else {
        rownorm_phase(p.xbuf, p.Y, nullptr, p.norm_final, nullptr, p.out, nullptr, nullptr, nullptr);
    }
}

__global__ void __launch_bounds__(256) trunk_kernel(Params p)
{
    __shared__ __attribute__((aligned(16))) u16 smem[3 * 128 * LDT];
    __shared__ uint4 xb_words;
    __shared__ int wsum[4];
    if (threadIdx.x == 0) xb_words = make_uint4(0u, 0u, 0u, 0u);
    __syncthreads();
    const XcdBarrier bar = xcd_barrier_post(p.bar, (volatile LAS unsigned*)&xb_words);
#pragma unroll 1
    for (int l = 0; l < 4; ++l) {
        run_phase<0>(p, l, smem, wsum); xcd_barrier(bar);
        run_phase<1>(p, l, smem, wsum); xcd_barrier(bar);
        run_phase<2>(p, l, smem, wsum); xcd_barrier(bar);
        run_phase<3>(p, l, smem, wsum); xcd_barrier(bar);
        run_phase<4>(p, l, smem, wsum); xcd_barrier(bar);
        if ((l & 1) == 0) {
            run_phase<5>(p, l, smem, wsum); xcd_barrier(bar);
            run_phase<6>(p, l, smem, wsum); xcd_barrier(bar);
        } else {
            run_phase<7>(p, l, smem, wsum); xcd_barrier(bar);
            run_phase<8>(p, l, smem, wsum); xcd_barrier(bar);
            run_phase<9>(p, l, smem, wsum); xcd_barrier(bar);
        }
    }
    run_phase<10>(p, 0, smem, wsum);
}

extern "C" void kernel_launch(void* const* d_in, const int* in_sizes, int n_in,
                              void* d_out, int out_size, void* d_ws, size_t ws_size,
                              hipStream_t stream)
{
    Params p{};
    p.x = (const float*)d_in[0]; p.norm_mix = (const float*)d_in[1]; p.w_in = (const float*)d_in[2];
    p.conv_w = (const float*)d_in[3]; p.lam_q1 = (const float*)d_in[4]; p.lam_k1 = (const float*)d_in[5];
    p.lam_q2 = (const float*)d_in[6]; p.lam_k2 = (const float*)d_in[7]; p.subln_g = (const float*)d_in[8];
    p.w_out = (const float*)d_in[9]; p.norm_ffn = (const float*)d_in[10]; p.ffn_w_gate = (const float*)d_in[11];
    p.ffn_w_up = (const float*)d_in[12]; p.ffn_w_down = (const float*)d_in[13]; p.router_w = (const float*)d_in[14];
    p.exp_w_gate = (const float*)d_in[15]; p.exp_w_up = (const float*)d_in[16]; p.exp_w_down = (const float*)d_in[17];
    p.norm_final = (const float*)d_in[18];
    p.out = (float*)d_out;
    char* ws = (char*)d_ws; size_t off = 0;
    auto take = [&](size_t bytes) { char* r = ws + off; off += (bytes + 255) & ~(size_t)255; return r; };
    p.bar = (unsigned*)take(16384);
    p.counts = (int*)take(256);
    p.cosT = (float*)take((size_t)SEQ * 32 * 4);
    p.sinT = (float*)take((size_t)SEQ * 32 * 4);
    p.xbuf = (float*)take((size_t)NTOK * DM * 4);
    p.h = (u16*)take((size_t)NTOK * DM * 2);
    p.mbuf = (u16*)take((size_t)NTOK * DM * 2);
    p.Vt = (u16*)take((size_t)NTOK * DM * 2);
    p.topi = (int*)take((size_t)NTOK * 2 * 4);
    p.topw = (float*)take((size_t)NTOK * 2 * 4);
    p.list = (int*)take((size_t)NEXP * NTOK * 4);
    p.R1 = (u16*)take((size_t)NTOK * INW * 2);
    p.Y = (float*)take((size_t)NTOK * 2 * DM * 4);
    p.w_in_t = (u16*)take((size_t)DM * INW * 2);
    p.w_out_t = (u16*)take((size_t)DM * DM * 2);
    p.wf = (u16*)take((size_t)3 * NEXP * DM * DFE * 2);
    if (off > ws_size) { fprintf(stderr, "kernel_launch: workspace too small (%zu > %zu)\n", off, ws_size); return; }

    int dev = 0, cus = 0, per_cu = 0;
    (void)hipGetDevice(&dev);
    (void)hipDeviceGetAttribute(&cus, hipDeviceAttributeMultiprocessorCount, dev);
    if (hipOccupancyMaxActiveBlocksPerMultiprocessor(&per_cu, (const void*)trunk_kernel, 256, 0) != hipSuccess || per_cu < 1) per_cu = 1;
    if (per_cu > 2) per_cu = 2;
    if (cus < 1) cus = 256;
    const int grid = cus * per_cu;
    (void)hipMemsetAsync(p.bar, 0, 16384, stream);
    hipLaunchKernelGGL(trunk_kernel, dim3(grid), dim3(256), 0, stream, p);
}
```

```cpp
#include <hip/hip_runtime.h>
#include <stdint.h>
#include <stdio.h>

typedef unsigned short u16;
using bf16x8 = __attribute__((ext_vector_type(8))) short;
using s16x4  = __attribute__((ext_vector_type(4))) short;
using f32x16 = __attribute__((ext_vector_type(16))) float;

#define MFMA16(a, b, c) __builtin_amdgcn_mfma_f32_32x32x16_bf16((a), (b), (c), 0, 0, 0)
#define MFMA8(a, b, c)  __builtin_amdgcn_mfma_f32_32x32x8bf16_1k((a), (b), (c), 0, 0, 0)

#define NTOK   16384
#define DM     1024
#define SEQ    2048
#define INW    8192
#define DFF    2816
#define DFE    3584
#define NEXP   8

#define XB_TMO      128
#define XB_XCNT(j)  (256  + 64 * (j))
#define XB_XSUB(j)  (1280 + 64 * (j))
#define XB_XGEN(j)  (2304 + 64 * (j))
#define XB_TOP      3328
#define XB_TOPGEN   3392
#define XCD_BAR_WORDS 3456
#define XB_SPIN_CAP (1u << 24)
#define LAS __attribute__((address_space(3)))

__device__ __forceinline__ unsigned xb_ld(unsigned* p)              { return __hip_atomic_load(p, __ATOMIC_RELAXED, __HIP_MEMORY_SCOPE_AGENT); }
__device__ __forceinline__ unsigned xb_add(unsigned* p, unsigned v) { return __hip_atomic_fetch_add(p, v, __ATOMIC_RELAXED, __HIP_MEMORY_SCOPE_AGENT); }
__device__ __forceinline__ unsigned xb_xcc_id() { return (unsigned)__builtin_amdgcn_s_getreg((3 << 11) | 20) & 0xFu; }
#define XB_SPIN(cond, bar) do { unsigned _sp = 0; while (cond) { __builtin_amdgcn_s_sleep(1); \
    if ((++_sp & 255u) == 0u) { if (xb_ld(&(bar)[XB_TMO])) break; if (_sp > XB_SPIN_CAP) { atomicAdd(&(bar)[XB_TMO], 1u); break; } } } } while (0)

struct XcdBarrier { unsigned* bar; unsigned x; volatile LAS unsigned* st; };

__device__ __forceinline__ XcdBarrier xcd_barrier_post(unsigned* bar, volatile LAS unsigned* st) {
    XcdBarrier b; b.bar = bar; b.x = xb_xcc_id(); b.st = st;
    if (threadIdx.x == 0) (void)xb_add(&bar[XB_XCNT(b.x)], 1u);
    return b;
}
__device__ __forceinline__ void xcd_barrier_complete(unsigned* bar, unsigned x, unsigned& nloc, unsigned& nx) {
    const unsigned G = gridDim.x * gridDim.y * gridDim.z;
    unsigned sum, cnt, mine, sp = 0u;
    for (;;) {
        sum = 0u; cnt = 0u; mine = 0u;
#pragma unroll
        for (unsigned j = 0; j < 16; ++j) { const unsigned c = xb_ld(&bar[XB_XCNT(j)]); sum += c; cnt += (c > 0u) ? 1u : 0u; mine = (j == x) ? c : mine; }
        if (sum == G) break;
        __builtin_amdgcn_s_sleep(1);
        if ((++sp & 255u) == 0u) { if (xb_ld(&bar[XB_TMO])) break; if (sp > XB_SPIN_CAP) { atomicAdd(&bar[XB_TMO], 1u); break; } }
    }
    nloc = mine > 0u ? mine : 1u; nx = cnt > 0u ? cnt : 1u;
}
__device__ __forceinline__ void xcd_barrier(const XcdBarrier b) {
    asm volatile("s_waitcnt vmcnt(0)" ::: "memory");
    __syncthreads();
    if (threadIdx.x == 0) {
        unsigned* bar = b.bar;
        __builtin_amdgcn_s_waitcnt(0);
        unsigned nloc = b.st[0], nx = b.st[1];
        if (nloc == 0u) { xcd_barrier_complete(bar, b.x, nloc, nx); b.st[0] = nloc; b.st[1] = nx; }
        const unsigned old = xb_add(&bar[XB_XSUB(b.x)], 1u);
        const unsigned gen = old / nloc;
        if (old + 1u == (gen + 1u) * nloc) {
            __builtin_amdgcn_fence(__ATOMIC_RELEASE, "agent");
            asm volatile("s_waitcnt vmcnt(0)" ::: "memory");
            const unsigned og = xb_add(&bar[XB_TOP], 1u);
            const unsigned tg = og / nx;
            if (og + 1u == (tg + 1u) * nx) xb_add(&bar[XB_TOPGEN], 1u);
            else XB_SPIN(xb_ld(&bar[XB_TOPGEN]) == tg, bar);
            __builtin_amdgcn_fence(__ATOMIC_ACQUIRE, "agent");
            xb_add(&bar[XB_XGEN(b.x)], 1u);
            asm volatile("s_waitcnt vmcnt(0)" ::: "memory");
        } else {
            XB_SPIN(xb_ld(&bar[XB_XGEN(b.x)]) == gen, bar);
            __builtin_amdgcn_fence(__ATOMIC_ACQUIRE, "agent");
            asm volatile("s_waitcnt vmcnt(0)" ::: "memory");
        }
    }
    __syncthreads();
}

__device__ __forceinline__ u16 f2bf(float f) {
    uint32_t u = __float_as_uint(f);
    u += 0x7fffu + ((u >> 16) & 1u);
    return (u16)(u >> 16);
}
__device__ __forceinline__ float bf2f(u16 h) { return __uint_as_float(((uint32_t)h) << 16); }
__device__ __forceinline__ float sigm(float x) { return 1.0f / (1.0f + __expf(-x)); }
__device__ __forceinline__ float wave_sum(float v) {
#pragma unroll
    for (int o = 32; o >= 1; o >>= 1) v += __shfl_xor(v, o);
    return v;
}

struct Params {
    const float *x, *norm_mix, *w_in, *conv_w, *lam_q1, *lam_k1, *lam_q2, *lam_k2, *subln_g, *w_out, *norm_ffn;
    const float *ffn_w_gate, *ffn_w_up, *ffn_w_down, *router_w, *exp_w_gate, *exp_w_up, *exp_w_down, *norm_final;
    float* out;
    unsigned* bar;
    int* counts;
    float* cosT;
    float* sinT;
    float* xbuf;
    u16* h;
    u16* mbuf;
    u16* Vt;
    int* topi;
    float* topw;
    int* list;
    u16* R1;
    float* Y;
    u16* w_in_t;
    u16* w_out_t;
    u16* wf;
};

struct EpiArgs {
    u16* proj; u16* Vt; const float* cosT; const float* sinT;
    float* xbuf;
    u16* H; int ldh; int orow_off;
    float* Y; const float* topw; const int* rowlist; int mvalid;
};

enum { EPI_INPROJ = 0, EPI_RESID = 1, EPI_SWIGLU = 2, EPI_MOEDOWN = 3 };

#define LDT 72

template <int EPI, bool DUAL>
__device__ __forceinline__ void gemm_tile(const u16* __restrict__ A, int lda, const int* __restrict__ gather, int mvalid, int m0,
                                          const u16* __restrict__ B0, const u16* __restrict__ B1, int K, int n0,
                                          const Params& p, int e_ldh, int e_orow, const int* e_rowlist, int e_mvalid, u16* smem)
{
    u16* As = smem; u16* Bs0 = smem + 128 * LDT; u16* Bs1 = smem + 2 * 128 * LDT;
    const int tid = threadIdx.x, lane = tid & 63, wave = tid >> 6;
    const int wm = (wave >> 1) * 64, wn = (wave & 1) * 64;
    const int l32 = lane & 31, half = lane >> 5;

    const int row0 = tid >> 3, sg8 = (tid & 7) * 8;
    int ar0 = m0 + row0, ar1 = ar0 + 32, ar2 = ar0 + 64, ar3 = ar0 + 96;
    if (gather) {
        ar0 = (ar0 < mvalid) ? (gather[ar0] >> 1) : 0; ar1 = (ar1 < mvalid) ? (gather[ar1] >> 1) : 0;
        ar2 = (ar2 < mvalid) ? (gather[ar2] >> 1) : 0; ar3 = (ar3 < mvalid) ? (gather[ar3] >> 1) : 0;
    }
    const u16* ap0 = A + (size_t)ar0 * lda + sg8;
    const u16* ap1 = A + (size_t)ar1 * lda + sg8;
    const u16* ap2 = A + (size_t)ar2 * lda + sg8;
    const u16* ap3 = A + (size_t)ar3 * lda + sg8;
    const u16* bpa = B0 + (size_t)(n0 + row0) * K + sg8;
    const u16* bpb = DUAL ? (B1 + (size_t)(n0 + row0) * K + sg8) : bpa;
    const size_t bst = (size_t)32 * K;
    const int so0 = row0 * LDT + sg8;
    const int sst = 32 * LDT;
    f32x16 acc[DUAL ? 2 : 1][2][2];
#pragma unroll
    for (int d = 0; d < (DUAL ? 2 : 1); ++d)
#pragma unroll
        for (int i = 0; i < 2; ++i)
#pragma unroll
            for (int j = 0; j < 2; ++j)
#pragma unroll
                for (int r = 0; r < 16; ++r) acc[d][i][j][r] = 0.f;

    uint4 ra0 = *(const uint4*)ap0, ra1 = *(const uint4*)ap1, ra2 = *(const uint4*)ap2, ra3 = *(const uint4*)ap3;
    uint4 rba0 = *(const uint4*)bpa, rba1 = *(const uint4*)(bpa + bst), rba2 = *(const uint4*)(bpa + 2 * bst), rba3 = *(const uint4*)(bpa + 3 * bst);
    uint4 rbb0 = rba0, rbb1 = rba1, rbb2 = rba2, rbb3 = rba3;
    if (DUAL) { rbb0 = *(const uint4*)bpb; rbb1 = *(const uint4*)(bpb + bst); rbb2 = *(const uint4*)(bpb + 2 * bst); rbb3 = *(const uint4*)(bpb + 3 * bst); }
    const int nk = K >> 6;
    for (int kt = 0; kt < nk; ++kt) {
        __syncthreads();
        *(uint4*)(As + so0) = ra0; *(uint4*)(As + so0 + sst) = ra1; *(uint4*)(As + so0 + 2 * sst) = ra2; *(uint4*)(As + so0 + 3 * sst) = ra3;
        *(uint4*)(Bs0 + so0) = rba0; *(uint4*)(Bs0 + so0 + sst) = rba1; *(uint4*)(Bs0 + so0 + 2 * sst) = rba2; *(uint4*)(Bs0 + so0 + 3 * sst) = rba3;
        if (DUAL) { *(uint4*)(Bs1 + so0) = rbb0; *(uint4*)(Bs1 + so0 + sst) = rbb1; *(uint4*)(Bs1 + so0 + 2 * sst) = rbb2; *(uint4*)(Bs1 + so0 + 3 * sst) = rbb3; }
        __syncthreads();
        if (kt + 1 < nk) {
            const int ko = (kt + 1) * 64;
            ra0 = *(const uint4*)(ap0 + ko); ra1 = *(const uint4*)(ap1 + ko); ra2 = *(const uint4*)(ap2 + ko); ra3 = *(const uint4*)(ap3 + ko);
            rba0 = *(const uint4*)(bpa + ko); rba1 = *(const uint4*)(bpa + bst + ko); rba2 = *(const uint4*)(bpa + 2 * bst + ko); rba3 = *(const uint4*)(bpa + 3 * bst + ko);
            if (DUAL) { rbb0 = *(const uint4*)(bpb + ko); rbb1 = *(const uint4*)(bpb + bst + ko); rbb2 = *(const uint4*)(bpb + 2 * bst + ko); rbb3 = *(const uint4*)(bpb + 3 * bst + ko); }
        }
#pragma unroll
        for (int ks = 0; ks < 4; ++ks) {
            bf16x8 af[2], bf[2], bg[2];
#pragma unroll
            for (int i = 0; i < 2; ++i) af[i] = *(const bf16x8*)(As + (wm + i * 32 + l32) * LDT + ks * 16 + half * 8);
#pragma unroll
            for (int j = 0; j < 2; ++j) {
                bf[j] = *(const bf16x8*)(Bs0 + (wn + j * 32 + l32) * LDT + ks * 16 + half * 8);
                if (DUAL) bg[j] = *(const bf16x8*)(Bs1 + (wn + j * 32 + l32) * LDT + ks * 16 + half * 8);
            }
#pragma unroll
            for (int i = 0; i < 2; ++i)
#pragma unroll
                for (int j = 0; j < 2; ++j) {
                    acc[0][i][j] = MFMA16(af[i], bf[j], acc[0][i][j]);
                    if (DUAL) acc[DUAL ? 1 : 0][i][j] = MFMA16(af[i], bg[j], acc[DUAL ? 1 : 0][i][j]);
                }
        }
    }

    if (EPI == EPI_INPROJ) {
        const int seg = n0 >> 10;
        if (seg < 2) {
            const float qs = (seg == 0) ? 0.125f : 1.0f;
#pragma unroll
            for (int i = 0; i < 2; ++i)
#pragma unroll
                for (int r = 0; r < 16; ++r) {
                    const int m = m0 + wm + i * 32 + (r >> 2) * 8 + half * 4 + (r & 3);
                    const int pos = m & (SEQ - 1);
                    const float c = p.cosT[pos * 32 + l32], s = p.sinT[pos * 32 + l32];
                    const float x1 = acc[0][i][0][r], x2 = acc[0][i][1][r];
                    const float o1 = (x1 * c - x2 * s) * qs, o2 = (x2 * c + x1 * s) * qs;
                    u16* dst = p.R1 + (size_t)m * INW + n0 + wn + l32;
                    dst[0] = f2bf(o1); dst[32] = f2bf(o2);
                }
        } else if (seg == 2) {
#pragma unroll
            for (int i = 0; i < 2; ++i)
#pragma unroll
                for (int j = 0; j < 2; ++j)
#pragma unroll
                    for (int rq = 0; rq < 4; ++rq) {
                        const int m = m0 + wm + i * 32 + rq * 8 + half * 4;
                        const int b = m >> 11, t = m & (SEQ - 1);
                        const int nn = n0 - 2048 + wn + j * 32 + l32;
                        ushort4 v;
                        v.x = f2bf(acc[0][i][j][rq * 4 + 0]); v.y = f2bf(acc[0][i][j][rq * 4 + 1]);
                        v.z = f2bf(acc[0][i][j][rq * 4 + 2]); v.w = f2bf(acc[0][i][j][rq * 4 + 3]);
                        *(ushort4*)(p.Vt + ((size_t)(b * 1024 + nn)) * SEQ + t) = v;
                    }
        } else {
#pragma unroll
            for (int i = 0; i < 2; ++i)
#pragma unroll
                for (int j = 0; j < 2; ++j)
#pragma unroll
                    for (int r = 0; r < 16; ++r) {
                        const int m = m0 + wm + i * 32 + (r >> 2) * 8 + half * 4 + (r & 3);
                        p.R1[(size_t)m * INW + n0 + wn + j * 32 + l32] = f2bf(acc[0][i][j][r]);
                    }
        }
    } else if (EPI == EPI_RESID) {
#pragma unroll
        for (int i = 0; i < 2; ++i)
#pragma unroll
            for (int j = 0; j < 2; ++j)
#pragma unroll
                for (int r = 0; r < 16; ++r) {
                    const int m = m0 + wm + i * 32 + (r >> 2) * 8 + half * 4 + (r & 3);
                    float* xp = p.xbuf + (size_t)m * DM + n0 + wn + j * 32 + l32;
                    *xp = *xp + acc[0][i][j][r];
                }
    } else if (EPI == EPI_SWIGLU) {
#pragma unroll
        for (int i = 0; i < 2; ++i)
#pragma unroll
            for (int j = 0; j < 2; ++j)
#pragma unroll
                for (int r = 0; r < 16; ++r) {
                    const int m = m0 + wm + i * 32 + (r >> 2) * 8 + half * 4 + (r & 3) + e_orow;
                    const float g = acc[0][i][j][r], u = acc[DUAL ? 1 : 0][i][j][r];
                    p.R1[(size_t)m * e_ldh + n0 + wn + j * 32 + l32] = f2bf(g * sigm(g) * u);
                }
    } else {
#pragma unroll
        for (int i = 0; i < 2; ++i)
#pragma unroll
            for (int r = 0; r < 16; ++r) {
                const int lm = m0 + wm + i * 32 + (r >> 2) * 8 + half * 4 + (r & 3);
                if (lm < e_mvalid) {
                    const int ent = e_rowlist[lm];
                    const float w = p.topw[ent];
#pragma unroll
                    for (int j = 0; j < 2; ++j)
                        p.Y[(size_t)ent * DM + n0 + wn + j * 32 + l32] = w * acc[0][i][j][r];
                }
            }
    }
}

__device__ void convert_job(const float* __restrict__ src, u16* __restrict__ dst, int K, int N, int batch, u16* T)
{
    const int tid = threadIdx.x;
    const int tk = K >> 6, tn = N >> 6; const int per = tk * tn; const int total = per * batch;
    const int kr = tid >> 4, n4 = (tid & 15) * 4;
    int tile = blockIdx.x;
    float4 v0 = make_float4(0.f, 0.f, 0.f, 0.f), v1 = v0, v2 = v0, v3 = v0;
    if (tile < total) {
        const int bi = tile / per; const int r = tile - bi * per; const int kt = r / tn, nt = r - kt * tn;
        const float* s = src + (size_t)bi * K * N + (size_t)(kt * 64 + kr) * N + nt * 64 + n4;
        v0 = *(const float4*)s; v1 = *(const float4*)(s + (size_t)16 * N);
        v2 = *(const float4*)(s + (size_t)32 * N); v3 = *(const float4*)(s + (size_t)48 * N);
    }
    while (tile < total) {
        const int bi = tile / per; const int r = tile - bi * per; const int kt = r / tn, nt = r - kt * tn;
        u16* d = dst + (size_t)bi * K * N + (size_t)(nt * 64) * K + kt * 64;
        __syncthreads();
        T[(n4 + 0) * 72 + kr] = f2bf(v0.x); T[(n4 + 1) * 72 + kr] = f2bf(v0.y); T[(n4 + 2) * 72 + kr] = f2bf(v0.z); T[(n4 + 3) * 72 + kr] = f2bf(v0.w);
        T[(n4 + 0) * 72 + kr + 16] = f2bf(v1.x); T[(n4 + 1) * 72 + kr + 16] = f2bf(v1.y); T[(n4 + 2) * 72 + kr + 16] = f2bf(v1.z); T[(n4 + 3) * 72 + kr + 16] = f2bf(v1.w);
        T[(n4 + 0) * 72 + kr + 32] = f2bf(v2.x); T[(n4 + 1) * 72 + kr + 32] = f2bf(v2.y); T[(n4 + 2) * 72 + kr + 32] = f2bf(v2.z); T[(n4 + 3) * 72 + kr + 32] = f2bf(v2.w);
        T[(n4 + 0) * 72 + kr + 48] = f2bf(v3.x); T[(n4 + 1) * 72 + kr + 48] = f2bf(v3.y); T[(n4 + 2) * 72 + kr + 48] = f2bf(v3.z); T[(n4 + 3) * 72 + kr + 48] = f2bf(v3.w);
        __syncthreads();
        const int nxt = tile + gridDim.x;
        if (nxt < total) {
            const int bi2 = nxt / per; const int r2 = nxt - bi2 * per; const int kt2 = r2 / tn, nt2 = r2 - kt2 * tn;
            const float* s = src + (size_t)bi2 * K * N + (size_t)(kt2 * 64 + kr) * N + nt2 * 64 + n4;
            v0 = *(const float4*)s; v1 = *(const float4*)(s + (size_t)16 * N);
            v2 = *(const float4*)(s + (size_t)32 * N); v3 = *(const float4*)(s + (size_t)48 * N);
        }
#pragma unroll
        for (int i = 0; i < 2; ++i) {
            const int c = tid + 256 * i; const int n = c >> 3, seg = c & 7;
            const uint4 v = *(const uint4*)(T + n * 72 + seg * 8);
            *(uint4*)(d + (size_t)n * K + seg * 8) = v;
        }
        tile = nxt;
    }
}

__device__ void rownorm_phase(const float* __restrict__ xsrc, const float* __restrict__ Y, float* __restrict__ xdst,
                              const float* __restrict__ g, u16* __restrict__ hout, float* __restrict__ fout,
                              const float* __restrict__ router, int* __restrict__ topi, float* __restrict__ topw)
{
    const int lane = threadIdx.x & 63, wave = threadIdx.x >> 6;
    for (int row = blockIdx.x * 4 + wave; row < NTOK; row += gridDim.x * 4) {
        float4 v[4]; float ss = 0.f;
#pragma unroll
        for (int i = 0; i < 4; ++i) {
            const int d = i * 256 + lane * 4;
            v[i] = *(const float4*)(xsrc + (size_t)row * DM + d);
            if (Y) {
                const float4 y0 = *(const float4*)(Y + (size_t)(row * 2) * DM + d);
                const float4 y1 = *(const float4*)(Y + (size_t)(row * 2 + 1) * DM + d);
                v[i].x += y0.x + y1.x; v[i].y += y0.y + y1.y; v[i].z += y0.z + y1.z; v[i].w += y0.w + y1.w;
            }
            if (xdst) *(float4*)(xdst + (size_t)row * DM + d) = v[i];
            ss += v[i].x * v[i].x + v[i].y * v[i].y + v[i].z * v[i].z + v[i].w * v[i].w;
        }
        ss = wave_sum(ss);
        const float rs = rsqrtf(ss * (1.0f / DM) + 1e-5f);
        float lg[8];
#pragma unroll
        for (int e = 0; e < 8; ++e) lg[e] = 0.f;
#pragma unroll
        for (int i = 0; i < 4; ++i) {
            const int d = i * 256 + lane * 4;
            const float4 gv = *(const float4*)(g + d);
            float4 y; y.x = v[i].x * rs * gv.x; y.y = v[i].y * rs * gv.y; y.z = v[i].z * rs * gv.z; y.w = v[i].w * rs * gv.w;
            if (hout) {
                ushort4 o; o.x = f2bf(y.x); o.y = f2bf(y.y); o.z = f2bf(y.z); o.w = f2bf(y.w);
                *(ushort4*)(hout + (size_t)row * DM + d) = o;
            }
            if (fout) *(float4*)(fout + (size_t)row * DM + d) = y;
            if (router) {
                const float yy[4] = {y.x, y.y, y.z, y.w};
#pragma unroll
                for (int jj = 0; jj < 4; ++jj) {
                    const float4 r0 = *(const float4*)(router + (size_t)(d + jj) * 8);
                    const float4 r1 = *(const float4*)(router + (size_t)(d + jj) * 8 + 4);
                    lg[0] += yy[jj] * r0.x; lg[1] += yy[jj] * r0.y; lg[2] += yy[jj] * r0.z; lg[3] += yy[jj] * r0.w;
                    lg[4] += yy[jj] * r1.x; lg[5] += yy[jj] * r1.y; lg[6] += yy[jj] * r1.z; lg[7] += yy[jj] * r1.w;
                }
            }
        }
        if (router) {
#pragma unroll
            for (int e = 0; e < 8; ++e) lg[e] = wave_sum(lg[e]);
            float b0 = lg[0]; int i0 = 0;
#pragma unroll
            for (int e = 1; e < 8; ++e) if (lg[e] > b0) { b0 = lg[e]; i0 = e; }
            float b1 = -3.0e38f; int i1 = 0;
#pragma unroll
            for (int e = 0; e < 8; ++e) if (e != i0 && lg[e] > b1) { b1 = lg[e]; i1 = e; }
            const float w0 = 1.0f / (1.0f + __expf(b1 - b0));
            if (lane == 0) {
                topi[row * 2] = i0; topi[row * 2 + 1] = i1;
                topw[row * 2] = w0; topw[row * 2 + 1] = 1.0f - w0;
            }
        }
    }
}

__device__ void attn_unit(const Params& p, int l, int b, int hh, int qb, float lam, float lam_init, u16* smem)
{
    u16* Ks = smem;
    u16* Vs = smem + 64 * 72;
    const int tid = threadIdx.x, lane = tid & 63, wave = tid >> 6;
    const int l32 = lane & 31, half = lane >> 5;
    const int q0 = qb * 128 + wave * 32;
    const int tq = q0 + l32;
    const u16* proj = p.R1;
    const size_t rowq = (size_t)(b * SEQ + tq) * INW;
    const int nkv = (qb * 128 + 128) >> 6;

    f32x16 res[4];
#pragma unroll 1
    for (int map = 0; map < 2; ++map) {
        bf16x8 qf[4];
#pragma unroll
        for (int ks = 0; ks < 4; ++ks) qf[ks] = *(const bf16x8*)(proj + rowq + (2 * hh + map) * 64 + ks * 16 + half * 8);
        float m_i = -1.0e30f, l_i = 0.f;
        f32x16 acc[4];
#pragma unroll
        for (int et = 0; et < 4; ++et)
#pragma unroll
            for (int r = 0; r < 16; ++r) acc[et][r] = 0.f;

        for (int kt = 0; kt < nkv; ++kt) {
            const int key0 = kt * 64;
            __syncthreads();
#pragma unroll
            for (int i = 0; i < 2; ++i) {
                const int c = tid + 256 * i; const int row = c >> 3, seg = c & 7;
                *(uint4*)(Ks + row * 72 + seg * 8) =
                    *(const uint4*)(proj + (size_t)(b * SEQ + key0 + row) * INW + 1024 + (2 * hh + map) * 64 + seg * 8);
            }
#pragma unroll
            for (int i = 0; i < 4; ++i) {
                const int c = tid + 256 * i; const int row = c >> 3, seg = c & 7;
                *(uint4*)(Vs + row * 72 + seg * 8) =
                    *(const uint4*)(p.Vt + ((size_t)((b * 8 + hh) * 128 + row)) * SEQ + key0 + seg * 8);
            }
            __syncthreads();
            if (key0 <= q0 + 31) {
                f32x16 st[2];
#pragma unroll
                for (int kb = 0; kb < 2; ++kb) {
#pragma unroll
                    for (int r = 0; r < 16; ++r) st[kb][r] = 0.f;
#pragma unroll
                    for (int ks = 0; ks < 4; ++ks) {
                        const bf16x8 kf = *(const bf16x8*)(Ks + (kb * 32 + l32) * 72 + ks * 16 + half * 8);
                        st[kb] = MFMA16(kf, qf[ks], st[kb]);
                    }
                }
                float mx = -1.0e30f;
#pragma unroll
                for (int kb = 0; kb < 2; ++kb)
#pragma unroll
                    for (int r = 0; r < 16; ++r) {
                        const int key = key0 + kb * 32 + (r >> 2) * 8 + half * 4 + (r & 3);
                        if (key > tq) st[kb][r] = -1.0e30f;
                        mx = fmaxf(mx, st[kb][r]);
                    }
                mx = fmaxf(mx, __shfl_xor(mx, 32));
                const float mnew = fmaxf(m_i, mx);
                const float alpha = __expf(m_i - mnew);
                float rsum = 0.f;
#pragma unroll
                for (int kb = 0; kb < 2; ++kb)
#pragma unroll
                    for (int r = 0; r < 16; ++r) { const float e = __expf(st[kb][r] - mnew); st[kb][r] = e; rsum += e; }
                rsum += __shfl_xor(rsum, 32);
                l_i = l_i * alpha + rsum; m_i = mnew;
#pragma unroll
                for (int et = 0; et < 4; ++et)
#pragma unroll
                    for (int r = 0; r < 16; ++r) acc[et][r] *= alpha;
#pragma unroll
                for (int kb = 0; kb < 2; ++kb)
#pragma unroll
                    for (int kk = 0; kk < 4; ++kk) {
                        s16x4 pb;
                        pb[0] = (short)f2bf(st[kb][kk * 4 + 0]); pb[1] = (short)f2bf(st[kb][kk * 4 + 1]);
                        pb[2] = (short)f2bf(st[kb][kk * 4 + 2]); pb[3] = (short)f2bf(st[kb][kk * 4 + 3]);
#pragma unroll
                        for (int et = 0; et < 4; ++et) {
                            const s16x4 vf = *(const s16x4*)(Vs + (et * 32 + l32) * 72 + kb * 32 + kk * 8 + half * 4);
                            acc[et] = MFMA8(vf, pb, acc[et]);
                        }
                    }
            }
        }
        const float inv = 1.0f / l_i;
        float* tmp = p.Y + (size_t)(b * SEQ + tq) * DM + hh * 128;
        if (map == 0) {
#pragma unroll
            for (int et = 0; et < 4; ++et)
#pragma unroll
                for (int rq = 0; rq < 4; ++rq) {
                    float4 v; v.x = acc[et][rq * 4 + 0] * inv; v.y = acc[et][rq * 4 + 1] * inv;
                    v.z = acc[et][rq * 4 + 2] * inv; v.w = acc[et][rq * 4 + 3] * inv;
                    *(float4*)(tmp + et * 32 + rq * 8 + half * 4) = v;
                }
        } else {
            const float li = lam * inv;
#pragma unroll
            for (int et = 0; et < 4; ++et)
#pragma unroll
                for (int rq = 0; rq < 4; ++rq) {
                    const float4 v = *(const float4*)(tmp + et * 32 + rq * 8 + half * 4);
                    res[et][rq * 4 + 0] = v.x - acc[et][rq * 4 + 0] * li; res[et][rq * 4 + 1] = v.y - acc[et][rq * 4 + 1] * li;
                    res[et][rq * 4 + 2] = v.z - acc[et][rq * 4 + 2] * li; res[et][rq * 4 + 3] = v.w - acc[et][rq * 4 + 3] * li;
                }
        }
    }
    float ss = 0.f;
#pragma unroll
    for (int et = 0; et < 4; ++et)
#pragma unroll
        for (int r = 0; r < 16; ++r) ss += res[et][r] * res[et][r];
    ss += __shfl_xor(ss, 32);
    const float rs = rsqrtf(ss * (1.0f / 128.0f) + 1e-5f) * (1.0f - lam_init);
    float* tmp2 = p.Y + (size_t)(b * SEQ + tq) * DM + hh * 128;
#pragma unroll
    for (int et = 0; et < 4; ++et)
#pragma unroll
        for (int rq = 0; rq < 4; ++rq) {
            float4 v; v.x = res[et][rq * 4 + 0] * rs; v.y = res[et][rq * 4 + 1] * rs;
            v.z = res[et][rq * 4 + 2] * rs; v.w = res[et][rq * 4 + 3] * rs;
            *(float4*)(tmp2 + et * 32 + rq * 8 + half * 4) = v;
        }
    const float* cw = p.conv_w + (size_t)l * 3 * DM;
    const float* sg = p.subln_g + (size_t)l * 128;
    const u16* r0p = proj + rowq;
    const u16* r1p = proj + rowq - INW;
    const u16* r2p = proj + rowq - 2 * INW;
    const bool h1 = tq >= 1, h2 = tq >= 2;
#pragma unroll 1
    for (int gi = 0; gi < 16; ++gi) {
        const int e4 = (gi >> 2) * 32 + (gi & 3) * 8 + half * 4;
        const int ch = hh * 128 + e4;
        const float4 yv = *(const float4*)(tmp2 + e4);
        const ushort4 bg = *(const ushort4*)(r0p + 3072 + ch);
        const ushort4 c0 = *(const ushort4*)(r0p + 4096 + ch);
        const ushort4 u0 = *(const ushort4*)(r0p + 5120 + ch);
        const ushort4 ga = *(const ushort4*)(r0p + 6144 + ch);
        const ushort4 gc = *(const ushort4*)(r0p + 7168 + ch);
        ushort4 c1 = make_ushort4(0, 0, 0, 0), u1 = c1, c2 = c1, u2 = c1;
        if (h1) { c1 = *(const ushort4*)(r1p + 4096 + ch); u1 = *(const ushort4*)(r1p + 5120 + ch); }
        if (h2) { c2 = *(const ushort4*)(r2p + 4096 + ch); u2 = *(const ushort4*)(r2p + 5120 + ch); }
        const float4 w0 = *(const float4*)(cw + ch);
        const float4 w1 = *(const float4*)(cw + DM + ch);
        const float4 w2 = *(const float4*)(cw + 2 * DM + ch);
        const float4 sgv = *(const float4*)(sg + e4);
        ushort4 o;
        {
            const float ya = yv.x * sgv.x;
            const float cv = w0.x * bf2f(c2.x) * bf2f(u2.x) + w1.x * bf2f(c1.x) * bf2f(u1.x) + w2.x * bf2f(c0.x) * bf2f(u0.x);
            o.x = f2bf(sigm(bf2f(ga.x)) * ya + sigm(bf2f(gc.x)) * bf2f(bg.x) * cv);
        }
        {
            const float ya = yv.y * sgv.y;
            const float cv = w0.y * bf2f(c2.y) * bf2f(u2.y) + w1.y * bf2f(c1.y) * bf2f(u1.y) + w2.y * bf2f(c0.y) * bf2f(u0.y);
            o.y = f2bf(sigm(bf2f(ga.y)) * ya + sigm(bf2f(gc.y)) * bf2f(bg.y) * cv);
        }
        {
            const float ya = yv.z * sgv.z;
            const float cv = w0.z * bf2f(c2.z) * bf2f(u2.z) + w1.z * bf2f(c1.z) * bf2f(u1.z) + w2.z * bf2f(c0.z) * bf2f(u0.z);
            o.z = f2bf(sigm(bf2f(ga.z)) * ya + sigm(bf2f(gc.z)) * bf2f(bg.z) * cv);
        }
        {
            const float ya = yv.w * sgv.w;
            const float cv = w0.w * bf2f(c2.w) * bf2f(u2.w) + w1.w * bf2f(c1.w) * bf2f(u1.w) + w2.w * bf2f(c0.w) * bf2f(u0.w);
            o.w = f2bf(sigm(bf2f(ga.w)) * ya + sigm(bf2f(gc.w)) * bf2f(bg.w) * cv);
        }
        *(ushort4*)(p.mbuf + (size_t)(b * SEQ + tq) * DM + ch) = o;
    }
}

template <int PH>
__device__ __forceinline__ void run_phase(const Params& p, int l, u16* smem, int* wsum)
{
    const int tid = threadIdx.x, lane = tid & 63, wave = tid >> 6;
    const int G = gridDim.x;
    const int j = l >> 1; const bool moe = (l & 1);

    if (PH == 0) {
        if (l == 0) {
            for (int idx = blockIdx.x * 256 + tid; idx < SEQ * 32; idx += G * 256) {
                const int pos = idx >> 5, jj = idx & 31;
                const float inv = exp2f(-(float)jj * (13.287712379549449f / 32.0f));
                const float ang = (float)pos * inv;
                double rev = (double)ang * 0.15915494309189535;
                rev -= rint(rev);
                p.cosT[idx] = __builtin_amdgcn_cosf((float)rev);
                p.sinT[idx] = __builtin_amdgcn_sinf((float)rev);
            }
        }
        convert_job(p.w_in + (size_t)l * DM * INW, p.w_in_t, DM, INW, 1, smem);
        convert_job(p.w_out + (size_t)l * DM * DM, p.w_out_t, DM, DM, 1, smem);
        if (!moe) {
            convert_job(p.ffn_w_gate + (size_t)j * DM * DFF, p.wf, DM, DFF, 1, smem);
            convert_job(p.ffn_w_up + (size_t)j * DM * DFF, p.wf + (size_t)DM * DFF, DM, DFF, 1, smem);
            convert_job(p.ffn_w_down + (size_t)j * DM * DFF, p.wf + (size_t)2 * DM * DFF, DFF, DM, 1, smem);
        } else {
            const size_t es = (size_t)NEXP * DM * DFE;
            convert_job(p.exp_w_gate + (size_t)j * es, p.wf, DM, DFE, NEXP, smem);
            convert_job(p.exp_w_up + (size_t)j * es, p.wf + es, DM, DFE, NEXP, smem);
            convert_job(p.exp_w_down + (size_t)j * es, p.wf + 2 * es, DFE, DM, NEXP, smem);
        }
        rownorm_phase(l == 0 ? p.x : p.xbuf, (l > 0 && ((l - 1) & 1)) ? p.Y : nullptr, p.xbuf,
                      p.norm_mix + (size_t)l * DM, p.h, nullptr, nullptr, nullptr, nullptr);
    } else if (PH == 1) {
        const int NT = INW / 128, total = (NTOK / 128) * NT;
        for (int tile = blockIdx.x; tile < total; tile += G) {
            const int mt = tile / NT, nt = tile - mt * NT;
            gemm_tile<EPI_INPROJ, false>(p.h, DM, nullptr, 0, mt * 128, p.w_in_t, nullptr, DM, nt * 128, p, 0, 0, nullptr, 0, smem);
        }
    } else if (PH == 2) {
        const float lam_init = 0.8f - 0.6f * expf(-0.3f * (float)l);
        float d1 = p.lam_q1[l * 64 + lane] * p.lam_k1[l * 64 + lane];
        float d2 = p.lam_q2[l * 64 + lane] * p.lam_k2[l * 64 + lane];
        d1 = wave_sum(d1); d2 = wave_sum(d2);
        const float lam = expf(d1) - expf(d2) + lam_init;
        for (int u = blockIdx.x; u < 1024; u += G) {
            const int qb = 15 - (u >> 6); const int bh = u & 63;
            attn_unit(p, l, bh >> 3, bh & 7, qb, lam, lam_init, smem);
        }
    } else if (PH == 3) {
        const int NT = DM / 128, total = (NTOK / 128) * NT;
        for (int tile = blockIdx.x; tile < total; tile += G) {
            const int mt = ((tile >> 3) / NT) * 8 + (tile & 7), nt = (tile >> 3) % NT;
            gemm_tile<EPI_RESID, false>(p.mbuf, DM, nullptr, 0, mt * 128, p.w_out_t, nullptr, DM, nt * 128, p, 0, 0, nullptr, 0, smem);
        }
    } else if (PH == 4) {
        rownorm_phase(p.xbuf, nullptr, nullptr, p.norm_ffn + (size_t)l * DM, p.h, nullptr,
                      moe ? (p.router_w + (size_t)j * DM * NEXP) : nullptr, p.topi, p.topw);
    } else if (PH == 5) {
        const int NT = DFF / 128, total = (NTOK / 128) * NT;
        for (int tile = blockIdx.x; tile < total; tile += G) {
            const int mt = tile / NT, nt = tile - mt * NT;
            gemm_tile<EPI_SWIGLU, true>(p.h, DM, nullptr, 0, mt * 128, p.wf, p.wf + (size_t)DM * DFF, DM, nt * 128, p, DFF, 0, nullptr, 0, smem);
        }
    } else if (PH == 6) {
        const int NT = DM / 128, total = (NTOK / 128) * NT;
        for (int tile = blockIdx.x; tile < total; tile += G) {
            const int mt = ((tile >> 3) / NT) * 8 + (tile & 7), nt = (tile >> 3) % NT;
            gemm_tile<EPI_RESID, false>(p.R1, DFF, nullptr, 0, mt * 128, p.wf + (size_t)2 * DM * DFF, nullptr, DFF, nt * 128, p, 0, 0, nullptr, 0, smem);
        }
    } else if (PH == 7) {
        if (blockIdx.x < NEXP) {
            const int e = blockIdx.x; int base = 0;
            for (int it = 0; it < NTOK / 256; ++it) {
                const int tok = it * 256 + tid;
                const int i0 = p.topi[tok * 2], i1 = p.topi[tok * 2 + 1];
                const int sel = (i0 == e) ? 0 : ((i1 == e) ? 1 : -1);
                const unsigned long long bal = __ballot(sel >= 0);
                const int wpos = __popcll(bal & ((1ull << lane) - 1ull));
                if (lane == 0) wsum[wave] = __popcll(bal);
                __syncthreads();
                int off = 0, tot = 0;
#pragma unroll
                for (int w = 0; w < 4; ++w) { const int sv = wsum[w]; if (w < wave) off += sv; tot += sv; }
                if (sel >= 0) p.list[e * NTOK + base + off + wpos] = tok * 2 + sel;
                base += tot;
                __syncthreads();
            }
            if (tid == 0) p.counts[e] = base;
        }
    } else if (PH == 8 || PH == 9) {
        const size_t es = (size_t)NEXP * DM * DFE;
        int tot_mt = 0;
        for (int i = 0; i < NEXP; ++i) tot_mt += (p.counts[i] + 127) >> 7;
        const int NT = (PH == 8) ? (DFE / 128) : (DM / 128);
        const int total = (PH == 8) ? (tot_mt * NT) : (((tot_mt + 7) & ~7) * NT);
        for (int tile = blockIdx.x; tile < total; tile += G) {
            const int mtg = (PH == 8) ? (tile / NT) : (((tile >> 3) / NT) * 8 + (tile & 7));
            const int nt = (PH == 8) ? (tile - mtg * NT) : ((tile >> 3) % NT);
            if (mtg >= tot_mt) continue;
            int e = 0, start = 0, cnt = 0, a = 0;
            for (int i = 0; i < NEXP; ++i) { const int c = p.counts[i]; const int mt = (c + 127) >> 7; if (mtg >= a && mtg < a + mt) { e = i; start = a; cnt = c; } a += mt; }
            const int ml = mtg - start;
            if (PH == 8)
                gemm_tile<EPI_SWIGLU, true>(p.h, DM, p.list + e * NTOK, cnt, ml * 128,
                                            p.wf + (size_t)e * DM * DFE, p.wf + es + (size_t)e * DM * DFE, DM, nt * 128, p, DFE, start * 128, nullptr, 0, smem);
            else
                gemm_tile<EPI_MOEDOWN, false>(p.R1 + (size_t)start * 128 * DFE, DFE, nullptr, 0, ml * 128,
                                              p.wf + 2 * es + (size_t)e * DM * DFE, nullptr, DFE, nt * 128, p, 0, 0, p.list + e * NTOK, cnt, smem);
        }
    } else {
        rownorm_phase(p.xbuf, p.Y, nullptr, p.norm_final, nullptr, p.out, nullptr, nullptr, nullptr);
    }
}

__global__ void __launch_bounds__(256) trunk_kernel(Params p)
{
    __shared__ __attribute__((aligned(16))) u16 smem[3 * 128 * LDT];
    __shared__ uint4 xb_words;
    __shared__ int wsum[4];
    if (threadIdx.x == 0) xb_words = make_uint4(0u, 0u, 0u, 0u);
    __syncthreads();
    const XcdBarrier bar = xcd_barrier_post(p.bar, (volatile LAS unsigned*)&xb_words);
#pragma unroll 1
    for (int l = 0; l < 4; ++l) {
        run_phase<0>(p, l, smem, wsum); xcd_barrier(bar);
        run_phase<1>(p, l, smem, wsum); xcd_barrier(bar);
        run_phase<2>(p, l, smem, wsum); xcd_barrier(bar);
        run_phase<3>(p, l, smem, wsum); xcd_barrier(bar);
        run_phase<4>(p, l, smem, wsum); xcd_barrier(bar);
        if ((l & 1) == 0) {
            run_phase<5>(p, l, smem, wsum); xcd_barrier(bar);
            run_phase<6>(p, l, smem, wsum); xcd_barrier(bar);
        } else {
            run_phase<7>(p, l, smem, wsum); xcd_barrier(bar);
            run_phase<8>(p, l, smem, wsum); xcd_barrier(bar);
            run_phase<9>(p, l, smem, wsum); xcd_barrier(bar);
        }
    }
    run_phase<10>(p, 0, smem, wsum);
}

extern "C" void kernel_launch(void* const* d_in, const int* in_sizes, int n_in,
                              void* d_out, int out_size, void* d_ws, size_t ws_size,
                              hipStream_t stream)
{
    Params p{};
    p.x = (const float*)d_in[0]; p.norm_mix = (const float*)d_in[1]; p.w_in = (const float*)d_in[2];
    p.conv_w = (const float*)d_in[3]; p.lam_q1 = (const float*)d_in[4]; p.lam_k1 = (const float*)d_in[5];
    p.lam_q2 = (const float*)d_in[6]; p.lam_k2 = (const float*)d_in[7]; p.subln_g = (const float*)d_in[8];
    p.w_out = (const float*)d_in[9]; p.norm_ffn = (const float*)d_in[10]; p.ffn_w_gate = (const float*)d_in[11];
    p.ffn_w_up = (const float*)d_in[12]; p.ffn_w_down = (const float*)d_in[13]; p.router_w = (const float*)d_in[14];
    p.exp_w_gate = (const float*)d_in[15]; p.exp_w_up = (const float*)d_in[16]; p.exp_w_down = (const float*)d_in[17];
    p.norm_final = (const float*)d_in[18];
    p.out = (float*)d_out;
    char* ws = (char*)d_ws; size_t off = 0;
    auto take = [&](size_t bytes) { char* r = ws + off; off += (bytes + 255) & ~(size_t)255; return r; };
    p.bar = (unsigned*)take(16384);
    p.counts = (int*)take(256);
    p.cosT = (float*)take((size_t)SEQ * 32 * 4);
    p.sinT = (float*)take((size_t)SEQ * 32 * 4);
    p.xbuf = (float*)take((size_t)NTOK * DM * 4);
    p.h = (u16*)take((size_t)NTOK * DM * 2);
    p.mbuf = (u16*)take((size_t)NTOK * DM * 2);
    p.Vt = (u16*)take((size_t)NTOK * DM * 2);
    p.topi = (int*)take((size_t)NTOK * 2 * 4);
    p.topw = (float*)take((size_t)NTOK * 2 * 4);
    p.list = (int*)take((size_t)NEXP * NTOK * 4);
    p.R1 = (u16*)take((size_t)NTOK * INW * 2);
    p.Y = (float*)take((size_t)NTOK * 2 * DM * 4);
    p.w_in_t = (u16*)take((size_t)DM * INW * 2);
    p.w_out_t = (u16*)take((size_t)DM * DM * 2);
    p.wf = (u16*)take((size_t)3 * NEXP * DM * DFE * 2);
    if (off > ws_size) { fprintf(stderr, "kernel_launch: workspace too small (%zu > %zu)\n", off, ws_size); return; }

    int dev = 0, cus = 0, per_cu = 0;
    (void)hipGetDevice(&dev);
    (void)hipDeviceGetAttribute(&cus, hipDeviceAttributeMultiprocessorCount, dev);
    if (hipOccupancyMaxActiveBlocksPerMultiprocessor(&per_cu, (const void*)trunk_kernel, 256, 0) != hipSuccess || per_cu < 1) per_cu = 1;
    if (per_cu > 2) per_cu = 2;
    if (cus < 1) cus = 256;
    const int grid = cus * per_cu;
    (void)hipMemsetAsync(p.bar, 0, 16384, stream);
    hipLaunchKernelGGL(trunk_kernel, dim3(grid), dim3(256), 0, stream, p);
}
```
